# Optimizing an MI355X kernel written in HIP

```python
import math
import jax
import jax.numpy as jnp
from jax import lax
import numpy as np

D_MODEL = 1024
BATCH = 32
SEQ = 2048
DEPTH = 2

GRID_W = 64
CTX_LEN = 256
EPS = 1e-6
N_MOD = 6
S5_WIDTH = D_MODEL // 4
S5_GROUP = 16
S5_GROUPS = S5_WIDTH // S5_GROUP
S5_STATE = 64
S5_DT_MIN = 1e-3
S5_DT_MAX = 1e-1
RET_HEADS = 4
RET_WIDTH = 3 * D_MODEL // 8
RET_DV = RET_WIDTH // RET_HEADS
RET_DK = RET_DV // 2
RET_CHUNK = 128
ROPE_BASE = 10000.0
GLA_HEADS = 4
GLA_WIDTH = 3 * D_MODEL // 8
GLA_DV = GLA_WIDTH // GLA_HEADS
GLA_DK = GLA_DV // 2
GLA_RANK = 16
GLA_TAU = 16.0
GLA_CHUNK = 64
FFN_HIDDEN = -(-8 * D_MODEL // (3 * 256)) * 256
IN_SIZES = (S5_WIDTH,
            RET_HEADS * RET_DK, RET_HEADS * RET_DK, RET_WIDTH, RET_WIDTH,
            GLA_HEADS * GLA_DK, GLA_HEADS * GLA_DK, GLA_WIDTH, GLA_WIDTH, GLA_RANK, GLA_RANK,
            D_MODEL, D_MODEL, D_MODEL)
IN_DIM = sum(IN_SIZES)

kernel_name = 'hybrid_s5_retnet_gla_prefix_dit'


def _rms_norm(x, gain):
    xf = x.astype(jnp.float32)
    y = xf * lax.rsqrt(jnp.mean(xf * xf, axis=-1, keepdims=True) + EPS)
    return (y * gain.astype(jnp.float32)).astype(x.dtype)


def _modulate(h, shift, scale):
    return h * (1.0 + scale) + shift


def _split_in(p):
    return jnp.split(p, np.cumsum(IN_SIZES)[:-1].tolist(), axis=-1)


def _heads(t, n_heads):
    b, l, _ = t.shape
    return t.reshape(b, l, n_heads, -1).transpose(0, 2, 1, 3)


def _merge_heads(t):
    b, h, l, d = t.shape
    return t.transpose(0, 2, 1, 3).reshape(b, l, h * d)


def _flip(t, rev, axis=2):
    return jnp.flip(t, axis) if rev else t


def _to_chunks(t, size):
    b, h, l, d = t.shape
    return jnp.moveaxis(t.reshape(b, h, l // size, size, d), 2, 0)


def _from_chunks(t):
    n, b, h, c, d = t.shape
    return jnp.moveaxis(t, 0, 2).reshape(b, h, n * c, d)


def _group_norm(o):
    mu = jnp.mean(o, axis=-1, keepdims=True)
    var = jnp.mean(jnp.square(o - mu), axis=-1, keepdims=True)
    return (o - mu) * lax.rsqrt(var + EPS)


def _head_rms(o):
    return o * lax.rsqrt(jnp.mean(o * o, axis=-1, keepdims=True) + EPS)


def _rope_2d(t, rows):
    nf = t.shape[-1] // 4
    inv = 1.0 / (ROPE_BASE ** (jnp.arange(nf, dtype=jnp.float32) / nf))
    r = jnp.repeat(jnp.arange(rows, dtype=jnp.float32), GRID_W)
    col = jnp.tile(jnp.arange(GRID_W, dtype=jnp.float32), rows)
    ang = jnp.concatenate([r[:, None] * inv, col[:, None] * inv], axis=-1)
    cos, sin = jnp.cos(ang), jnp.sin(ang)
    t1, t2 = t[..., 0::2], t[..., 1::2]
    return jnp.stack([t1 * cos - t2 * sin, t1 * sin + t2 * cos], axis=-1).reshape(t.shape)


def _s5_discretize(lam_re, lam_im, log_dt, b_re, b_im):
    dt = jnp.exp(log_dt)[:, None]
    mag = jnp.exp(lam_re * dt)
    a_re, a_im = mag * jnp.cos(lam_im * dt), mag * jnp.sin(lam_im * dt)
    den = lam_re * lam_re + lam_im * lam_im
    f_re = ((a_re - 1.0) * lam_re + a_im * lam_im) / den
    f_im = (a_im * lam_re - (a_re - 1.0) * lam_im) / den
    bb_re = f_re[..., None] * b_re - f_im[..., None] * b_im
    bb_im = f_re[..., None] * b_im + f_im[..., None] * b_re
    return a_re, a_im, bb_re, bb_im


def _s5_scan(x_re, x_im, a_re, a_im, h0_re, h0_im):
    l = x_re.shape[1]
    ar = jnp.broadcast_to(a_re, (1, l) + a_re.shape)
    ai = jnp.broadcast_to(a_im, (1, l) + a_im.shape)

    def combine(e1, e2):
        a1r, a1i, x1r, x1i = e1
        a2r, a2i, x2r, x2i = e2
        return (a2r * a1r - a2i * a1i, a2r * a1i + a2i * a1r,
                a2r * x1r - a2i * x1i + x2r, a2r * x1i + a2i * x1r + x2i)

    pr, pi, hr, hi = lax.associative_scan(combine, (ar, ai, x_re, x_im), axis=1)
    h0r, h0i = h0_re[:, None], h0_im[:, None]
    return hr + pr * h0r - pi * h0i, hi + pr * h0i + pi * h0r


def _s5_branch(u_ctx, u_lat, lam_re, lam_im, log_dt, b_re, b_im, c_re, c_im, d_skip, glu_w, glu_b, need_ctx):
    f32 = jnp.float32
    lam_re, lam_im, log_dt, b_re, b_im, c_re, c_im, d_skip, glu_w, glu_b = (
        t.astype(f32) for t in (lam_re, lam_im, log_dt, b_re, b_im, c_re, c_im, d_skip, glu_w, glu_b))
    u_c, u_l = u_ctx.astype(f32), u_lat.astype(f32)
    bsz = u_l.shape[0]
    grp_c = u_c.reshape(bsz, u_c.shape[1], S5_GROUPS, S5_GROUP)
    grp_l = u_l.reshape(bsz, u_l.shape[1], S5_GROUPS, S5_GROUP)
    zeros = jnp.zeros((bsz, S5_GROUPS, S5_STATE), f32)
    hc_re = hc_im = hl_re = hl_im = 0.0
    for d in range(2):
        rev = d == 1
        a_re, a_im, bb_re, bb_im = _s5_discretize(lam_re[d], lam_im[d], log_dt[d], b_re, b_im)
        xc = [_flip(jnp.einsum('blgc,gpc->blgp', grp_c, bb), rev, 1) for bb in (bb_re, bb_im)]
        xl = [_flip(jnp.einsum('blgc,gpc->blgp', grp_l, bb), rev, 1) for bb in (bb_re, bb_im)]
        sc_re, sc_im = _s5_scan(xc[0], xc[1], a_re, a_im, zeros, zeros)
        sl_re, sl_im = _s5_scan(xl[0], xl[1], a_re, a_im, sc_re[:, -1], sc_im[:, -1])
        hc_re, hc_im = hc_re + _flip(sc_re, rev, 1), hc_im + _flip(sc_im, rev, 1)
        hl_re, hl_im = hl_re + _flip(sl_re, rev, 1), hl_im + _flip(sl_im, rev, 1)

    def readout(h_re, h_im, u):
        y = jnp.einsum('blgp,gcp->blgc', h_re, c_re) - jnp.einsum('blgp,gcp->blgc', h_im, c_im)
        y = jax.nn.gelu(y.reshape(u.shape) + d_skip * u)
        return y * jax.nn.sigmoid(y @ glu_w + glu_b)

    y_l = readout(hl_re, hl_im, u_l).astype(u_lat.dtype)
    y_c = readout(hc_re, hc_im, u_c).astype(u_ctx.dtype) if need_ctx else None
    return y_c, y_l


def _retention_chunked(q, k, v, log_gamma, s0):
    pos = jnp.arange(RET_CHUNK, dtype=jnp.float32)
    rel = pos[:, None] - pos[None, :]
    intra = jnp.where(rel >= 0, jnp.exp(jnp.maximum(rel, 0.0) * log_gamma[:, None, None]), 0.0)
    q_dec = jnp.exp((pos + 1.0) * log_gamma[:, None])[..., None]
    k_dec = jnp.exp((RET_CHUNK - 1.0 - pos) * log_gamma[:, None])[..., None]
    c_dec = jnp.exp(RET_CHUNK * log_gamma)[:, None, None]

    def step(s, blk):
        qc, kc, vc = blk
        att = jnp.einsum('bhid,bhjd->bhij', qc, kc) * intra
        o = jnp.einsum('bhij,bhjv->bhiv', att, vc) + jnp.einsum('bhid,bhdv->bhiv', qc * q_dec, s)
        s = c_dec * s + jnp.einsum('bhjd,bhjv->bhdv', kc * k_dec, vc)
        return s, o

    s_fin, o = lax.scan(step, s0, (_to_chunks(q, RET_CHUNK), _to_chunks(k, RET_CHUNK), _to_chunks(v, RET_CHUNK)))
    return _from_chunks(o), s_fin


def _retnet_branch(p_ctx, p_lat, log_decay, gn_gain, rows, need_ctx):
    f32 = jnp.float32
    log_decay, gn_gain = log_decay.astype(f32), gn_gain.astype(f32)

    def prep(p, rotate):
        q, k, v, g = (t.astype(f32) for t in p)
        q, k, v = _heads(q, RET_HEADS), _heads(k, RET_HEADS), _heads(v, RET_HEADS)
        if rotate:
            q, k = _rope_2d(q, rows), _rope_2d(k, rows)
        return q, k * RET_DK ** -0.5, v, g

    qc, kc, vc, gc = prep(p_ctx, False)
    ql, kl, vl, gl = prep(p_lat, True)
    zeros = jnp.zeros((ql.shape[0], RET_HEADS, RET_DK, RET_DV), f32)
    o_c = o_l = 0.0
    for d in range(2):
        rev = d == 1
        oc, s_ctx = _retention_chunked(_flip(qc, rev), _flip(kc, rev), _flip(vc, rev), log_decay[d], zeros)
        ol, _ = _retention_chunked(_flip(ql, rev), _flip(kl, rev), _flip(vl, rev), log_decay[d], s_ctx)
        o_c = o_c + _flip(oc, rev)
        o_l = o_l + _flip(ol, rev)

    def readout(o, g, dtype):
        return (_merge_heads(_group_norm(o)) * gn_gain * jax.nn.silu(g)).astype(dtype)

    y_l = readout(o_l, gl, p_lat[0].dtype)
    y_c = readout(o_c, gc, p_ctx[0].dtype) if need_ctx else None
    return y_c, y_l


def _gla_chunked(q, k, v, log_alpha, s0):
    mask = jnp.tril(jnp.ones((GLA_CHUNK, GLA_CHUNK), dtype=bool))

    def step(s, blk):
        qc, kc, vc, gc = blk
        b = jnp.cumsum(gc, axis=-2)
        b_last = b[..., -1:, :]
        q_t = qc * jnp.exp(b)
        k_t = kc * jnp.exp(-b)
        att = jnp.where(mask, jnp.einsum('bhid,bhjd->bhij', q_t, k_t), 0.0)
        o = jnp.einsum('bhij,bhjv->bhiv', att, vc) + jnp.einsum('bhid,bhdv->bhiv', q_t, s)
        s = jnp.exp(b_last)[..., 0, :, None] * s + jnp.einsum('bhjd,bhjv->bhdv', kc * jnp.exp(b_last - b), vc)
        return s, o

    xs = tuple(_to_chunks(t, GLA_CHUNK) for t in (q, k, v, log_alpha))
    s_fin, o = lax.scan(step, s0, xs)
    return _from_chunks(o), s_fin


def _gla_branch(p_ctx, p_lat, gate_w, gate_b, norm_gain, need_ctx):
    f32 = jnp.float32
    gate_w, gate_b, norm_gain = gate_w.astype(f32), gate_b.astype(f32), norm_gain.astype(f32)

    def prep(p):
        q, k, v, g, z_f, z_b = (t.astype(f32) for t in p)
        la = tuple(_heads(jax.nn.log_sigmoid(z @ gate_w[d] + gate_b[d]) / GLA_TAU, GLA_HEADS)
                   for d, z in enumerate((z_f, z_b)))
        return (_heads(q, GLA_HEADS) * GLA_DK ** -0.5, _heads(k, GLA_HEADS), _heads(v, GLA_HEADS), la, g)

    qc, kc, vc, lac, gc = prep(p_ctx)
    ql, kl, vl, lal, gl = prep(p_lat)
    zeros = jnp.zeros((ql.shape[0], GLA_HEADS, GLA_DK, GLA_DV), f32)
    o_c = o_l = 0.0
    for d in range(2):
        rev = d == 1
        oc, s_ctx = _gla_chunked(_flip(qc, rev), _flip(kc, rev), _flip(vc, rev), _flip(lac[d], rev), zeros)
        ol, _ = _gla_chunked(_flip(ql, rev), _flip(kl, rev), _flip(vl, rev), _flip(lal[d], rev), s_ctx)
        o_c = o_c + _flip(oc, rev)
        o_l = o_l + _flip(ol, rev)

    def readout(o, g, dtype):
        return (_merge_heads(_head_rms(o)) * norm_gain * jax.nn.silu(g)).astype(dtype)

    y_l = readout(o_l, gl, p_lat[0].dtype)
    y_c = readout(o_c, gc, p_ctx[0].dtype) if need_ctx else None
    return y_c, y_l


def _merge_branches(ys, gates, w_brs, w_out):
    m = jax.nn.sigmoid(gates[0]) * (ys[0] @ w_brs[0])
    for y, g, w in zip(ys[1:], gates[1:], w_brs[1:]):
        m = m + jax.nn.sigmoid(g) * (y @ w)
    return m @ w_out


def _swiglu(h, w_in, w_out):
    a, b = jnp.split(h @ w_in, 2, axis=-1)
    return (jax.nn.silu(a) * b) @ w_out


def setup_inputs(seed: int = 0) -> dict:
    key = jax.random.key(seed)
    ks = iter(jax.random.split(key, 40))
    f32 = jnp.float32

    def nrm(shape, scale):
        return scale * jax.random.normal(next(ks), shape, f32)

    G, P = S5_GROUPS, S5_STATE
    hippo_im = jnp.pi * jnp.arange(P, dtype=f32)
    ret_base = jnp.log(1.0 - 2.0 ** (-5.0 - jnp.arange(RET_HEADS, dtype=f32)))
    return dict(
        x=nrm((BATCH, SEQ, D_MODEL), 1.0),
        c=nrm((BATCH, D_MODEL), 1.0),
        ctx=nrm((BATCH, CTX_LEN, D_MODEL), 1.0),
        c_ctx=nrm((D_MODEL,), 1.0),
        w_mod=nrm((DEPTH, D_MODEL, N_MOD * D_MODEL), D_MODEL ** -0.5),
        b_mod=nrm((DEPTH, N_MOD * D_MODEL), 0.01),
        norm_mix=1.0 + nrm((DEPTH, D_MODEL), 0.01),
        norm_ffn=1.0 + nrm((DEPTH, D_MODEL), 0.01),
        w_in=nrm((DEPTH, D_MODEL, IN_DIM), D_MODEL ** -0.5),
        s5_lam_re=-0.5 + nrm((DEPTH, 2, G, P), 0.01),
        s5_lam_im=hippo_im + nrm((DEPTH, 2, G, P), 0.01),
        s5_log_dt=jax.random.uniform(next(ks), (DEPTH, 2, G), f32, math.log(S5_DT_MIN), math.log(S5_DT_MAX)),
        s5_b_re=nrm((DEPTH, G, P, S5_GROUP), (2 * S5_GROUP) ** -0.5),
        s5_b_im=nrm((DEPTH, G, P, S5_GROUP), (2 * S5_GROUP) ** -0.5),
        s5_c_re=nrm((DEPTH, G, S5_GROUP, P), P ** -0.5),
        s5_c_im=nrm((DEPTH, G, S5_GROUP, P), P ** -0.5),
        s5_d=nrm((DEPTH, S5_WIDTH), 1.0),
        s5_glu_w=nrm((DEPTH, S5_WIDTH, S5_WIDTH), S5_WIDTH ** -0.5),
        s5_glu_b=nrm((DEPTH, S5_WIDTH), 0.01),
        ret_log_decay=ret_base * (1.0 + nrm((DEPTH, 2, RET_HEADS), 0.05)),
        ret_gn=1.0 + nrm((DEPTH, RET_WIDTH), 0.01),
        gla_gate_w=nrm((DEPTH, 2, GLA_RANK, GLA_HEADS * GLA_DK), GLA_RANK ** -0.5),
        gla_gate_b=nrm((DEPTH, 2, GLA_HEADS * GLA_DK), 0.1),
        gla_norm=1.0 + nrm((DEPTH, GLA_WIDTH), 0.01),
        w_br_s5=nrm((DEPTH, S5_WIDTH, D_MODEL), S5_WIDTH ** -0.5),
        w_br_ret=nrm((DEPTH, RET_WIDTH, D_MODEL), RET_WIDTH ** -0.5),
        w_br_gla=nrm((DEPTH, GLA_WIDTH, D_MODEL), GLA_WIDTH ** -0.5),
        w_out=nrm((DEPTH, D_MODEL, D_MODEL), D_MODEL ** -0.5),
        w_ffn_in=nrm((DEPTH, D_MODEL, 2 * FFN_HIDDEN), D_MODEL ** -0.5),
        w_ffn_out=nrm((DEPTH, FFN_HIDDEN, D_MODEL), FFN_HIDDEN ** -0.5),
        norm_final=1.0 + nrm((D_MODEL,), 0.01),
    )


def reference(x, c, ctx, c_ctx, w_mod, b_mod, norm_mix, norm_ffn, w_in,
              s5_lam_re, s5_lam_im, s5_log_dt, s5_b_re, s5_b_im, s5_c_re, s5_c_im, s5_d, s5_glu_w, s5_glu_b,
              ret_log_decay, ret_gn, gla_gate_w, gla_gate_b, gla_norm,
              w_br_s5, w_br_ret, w_br_gla, w_out, w_ffn_in, w_ffn_out, norm_final):
    rows = x.shape[1] // GRID_W
    s_c = jax.nn.silu(c)
    s_cc = jax.nn.silu(c_ctx)
    for l in range(DEPTH):
        need_ctx = l < DEPTH - 1
        m_l = jnp.split((s_c @ w_mod[l] + b_mod[l])[:, None, :], N_MOD, axis=-1)
        m_c = jnp.split(s_cc @ w_mod[l] + b_mod[l], N_MOD, axis=-1)
        p_l = _split_in(_modulate(_rms_norm(x, norm_mix[l]), m_l[0], m_l[1]) @ w_in[l])
        p_c = _split_in(_modulate(_rms_norm(ctx, norm_mix[l]), m_c[0], m_c[1]) @ w_in[l])
        s5_c, s5_l = _s5_branch(p_c[0], p_l[0], s5_lam_re[l], s5_lam_im[l], s5_log_dt[l], s5_b_re[l], s5_b_im[l],
                                s5_c_re[l], s5_c_im[l], s5_d[l], s5_glu_w[l], s5_glu_b[l], need_ctx)
        ret_c, ret_l = _retnet_branch(p_c[1:5], p_l[1:5], ret_log_decay[l], ret_gn[l], rows, need_ctx)
        gla_c, gla_l = _gla_branch(p_c[5:11], p_l[5:11], gla_gate_w[l], gla_gate_b[l], gla_norm[l], need_ctx)
        w_brs = (w_br_s5[l], w_br_ret[l], w_br_gla[l])
        x = x + m_l[2] * _merge_branches((s5_l, ret_l, gla_l), p_l[11:14], w_brs, w_out[l])
        x = x + m_l[5] * _swiglu(_modulate(_rms_norm(x, norm_ffn[l]), m_l[3], m_l[4]), w_ffn_in[l], w_ffn_out[l])
        if need_ctx:
            ctx = ctx + m_c[2] * _merge_branches((s5_c, ret_c, gla_c), p_c[11:14], w_brs, w_out[l])
            ctx = ctx + m_c[5] * _swiglu(_modulate(_rms_norm(ctx, norm_ffn[l]), m_c[3], m_c[4]),
                                         w_ffn_in[l], w_ffn_out[l])
    return _rms_norm(x, norm_final)
```

```cpp
#include <hip/hip_runtime.h>
#include <hip/hip_cooperative_groups.h>
#include <cstdio>
namespace cg = cooperative_groups;

#define LAS __attribute__((address_space(3)))
typedef unsigned short bf16_t;
typedef short bf16x8 __attribute__((ext_vector_type(8)));
typedef float f32x4 __attribute__((ext_vector_type(4)));
typedef float f32x16 __attribute__((ext_vector_type(16)));
typedef unsigned u32x4 __attribute__((ext_vector_type(4)));
typedef unsigned u32x2 __attribute__((ext_vector_type(2)));

constexpr int D = 1024, NB = 32, SEQ = 2048, CTXL = 256, TOK = 2304, MROWS = NB * TOK;
constexpr int NRT = MROWS / 256;
constexpr int NMIX = 2816, NGATE = 3072, FFH = 2816, NFFI = 5632, INDIM = 5664, PMLD = 2560;
constexpr float EPS = 1e-6f;
constexpr int LDS_BYTES = 160 * 1024;

constexpr size_t al256(size_t x) { return (x + 255) & ~(size_t)255; }
constexpr size_t WL_MIX = 0;
constexpr size_t WL_G = WL_MIX + (size_t)NMIX * 1024;
constexpr size_t WL_BR = WL_G + (size_t)NGATE * 1024;
constexpr size_t WL_OUT = WL_BR + (size_t)1024 * 1024;
constexpr size_t WL_FFI = WL_OUT + (size_t)1024 * 1024;
constexpr size_t WL_FFO = WL_FFI + (size_t)NFFI * 1024;
constexpr size_t WL_GLU = WL_FFO + (size_t)1024 * FFH;
constexpr size_t WL_KCAT = WL_GLU + (size_t)256 * 256;
constexpr size_t WL_WST = WL_KCAT + (size_t)16 * 512 * 768;
constexpr size_t WL_END = WL_WST + (size_t)16 * 256 * 512;
constexpr size_t TL_AP = 0;
constexpr size_t TL_BB = TL_AP + (size_t)16 * 2 * 64 * 33 * 2;
constexpr size_t TL_KT = TL_BB + (size_t)16 * 2 * 64 * 16 * 2;
constexpr size_t TL_END = TL_KT + (size_t)16 * 2 * 32 * 256;

constexpr size_t WS_W = 0;
constexpr size_t WS_T = al256(WS_W + 2 * WL_END * 2);
constexpr size_t WS_MOD = al256(WS_T + 2 * TL_END * 4);
constexpr size_t WS_ROPE = al256(WS_MOD + (size_t)2 * 33 * 6144 * 4);
constexpr size_t WS_CTX = al256(WS_ROPE + (size_t)2048 * 24 * 2 * 4);
constexpr size_t WS_XN = al256(WS_CTX + (size_t)8192 * 1024 * 4);
constexpr size_t ST_ELEMS = (size_t)2 * 32 * 4 * 2 * 36 * 4608;
constexpr size_t WS_ST = WS_XN;
constexpr size_t WS_DEC = al256(WS_XN + ST_ELEMS * 2);
constexpr size_t WS_R1 = al256(WS_DEC + (size_t)2 * 32 * 36 * 4 * 2 * 48 * 4);
constexpr size_t WS_PM = WS_R1;
constexpr size_t WS_UH = al256(WS_PM + (size_t)MROWS * PMLD * 2);
constexpr size_t WS_YB = WS_R1;
constexpr size_t WS_H = WS_R1;
constexpr size_t WS_R2 = al256(WS_R1 + (size_t)MROWS * 3072 * 2);
constexpr size_t WS_Y = WS_R2;
constexpr size_t WS_M1 = WS_R1 + (size_t)64 * 1024 * 1024;
constexpr size_t WS_Y5 = al256(WS_R2 + (size_t)MROWS * 1024 * 2);
constexpr size_t WS_SS = al256(WS_Y5 + (size_t)MROWS * 256 * 2);
constexpr size_t WS_BAR = al256(WS_SS + (size_t)16 * 2304 * 256 * 4);
constexpr size_t BAR_BYTES = 3456 * 4;
constexpr size_t WS_EX = al256(WS_BAR + BAR_BYTES);
constexpr size_t WS_END = al256(WS_EX + (size_t)MROWS * 384 * 2);
static_assert(WS_UH + (size_t)16 * 2304 * 768 * 2 <= WS_R2, "R1 overflow");

typedef __bf16 bf16v2_t __attribute__((ext_vector_type(2)));
typedef float f32v2_t __attribute__((ext_vector_type(2)));
__device__ __forceinline__ unsigned pk2(float lo, float hi) { const f32v2_t v = {lo, hi}; const bf16v2_t b = __builtin_convertvector(v, bf16v2_t); return __builtin_bit_cast(unsigned, b); }
__device__ __forceinline__ bf16_t f2bf(float f) { return (bf16_t)(pk2(f, 0.f) & 0xffffu); }
__device__ __forceinline__ float bf2f(unsigned v) { return __uint_as_float(v << 16); }
__device__ __forceinline__ float bflo(unsigned w) { return __uint_as_float(w << 16); }
__device__ __forceinline__ float bfhi(unsigned w) { return __uint_as_float(w & 0xffff0000u); }
__device__ __forceinline__ void unpack8(const u32x4 w, float (&f)[8]) { f[0] = bflo(w.x); f[1] = bfhi(w.x); f[2] = bflo(w.y); f[3] = bfhi(w.y); f[4] = bflo(w.z); f[5] = bfhi(w.z); f[6] = bflo(w.w); f[7] = bfhi(w.w); }
__device__ __forceinline__ float sigmoidf_(float x) { return 1.0f / (1.0f + __expf(-x)); }
__device__ __forceinline__ float siluf_(float x) { return x / (1.0f + __expf(-x)); }
__device__ __forceinline__ float geluf_(float x) { const float z = 1.5957691216057308f * (x + 0.044715f * x * x * x); return x / (1.0f + __expf(-z)); }
__device__ __forceinline__ float wave_sum(float v) {
#pragma unroll
    for (int o = 1; o < 64; o <<= 1) v += __shfl_xor(v, o);
    return v;
}
#define GSYNC() do { asm volatile("s_waitcnt vmcnt(0) lgkmcnt(0)" ::: "memory"); grid.sync(); } while (0)
__device__ __forceinline__ size_t pm_off(size_t row, int col) { return (((row >> 6) * (size_t)(PMLD / 8) + (size_t)(col >> 3)) << 9) + ((row & 63) << 3) + (size_t)(col & 7); }
__device__ __forceinline__ size_t ex_off(size_t row, int col) { return (((row >> 6) * (size_t)48 + (size_t)(col >> 3)) << 9) + ((row & 63) << 3) + (size_t)(col & 7); }
#define LDS_WAIT() asm volatile("s_waitcnt lgkmcnt(0)" ::: "memory")
__device__ __forceinline__ int fresh_tid() { int t = threadIdx.x; asm volatile("" : "+v"(t)); return t; }

#define XB_TMO      128
#define XB_XCNT(j)  (256  + 64 * (j))
#define XB_XSUB(j)  (1280 + 64 * (j))
#define XB_XGEN(j)  (2304 + 64 * (j))
#define XB_TOP      3328
#define XB_TOPGEN   3392
#define XCD_BAR_WORDS 3456
#define XB_SPIN_CAP (1u << 18)

__device__ __forceinline__ unsigned xb_ld(unsigned* p)              { return __hip_atomic_load(p, __ATOMIC_RELAXED, __HIP_MEMORY_SCOPE_AGENT); }
__device__ __forceinline__ unsigned xb_add(unsigned* p, unsigned v) { return __hip_atomic_fetch_add(p, v, __ATOMIC_RELAXED, __HIP_MEMORY_SCOPE_AGENT); }
__device__ __forceinline__ unsigned xb_xcc_id() { return (unsigned)__builtin_amdgcn_s_getreg((3 << 11) | 20) & 0xFu; }
#define XB_SPIN(cond, bar) do { unsigned _sp = 0; while (cond) { __builtin_amdgcn_s_sleep(1); \
    if ((++_sp & 255u) == 0u) { if (xb_ld(&(bar)[XB_TMO])) break; if (_sp > XB_SPIN_CAP) { atomicAdd(&(bar)[XB_TMO], 1u); break; } } } } while (0)

struct XcdBarrier {
    unsigned* bar; unsigned x;
    volatile LAS unsigned* st;
};

__device__ __forceinline__ XcdBarrier xcd_barrier_post(unsigned* bar, volatile LAS unsigned* st) {
    XcdBarrier b; b.bar = bar; b.x = xb_xcc_id(); b.st = st;
    if (threadIdx.x == 0) (void)xb_add(&bar[XB_XCNT(b.x)], 1u);
    return b;
}
__device__ __forceinline__ void xcd_barrier_complete(unsigned* bar, unsigned x, unsigned& nloc, unsigned& nx) {
    const unsigned G = gridDim.x * gridDim.y * gridDim.z;
    unsigned sum, cnt, mine, sp = 0u;
    for (;;) {
        sum = 0u; cnt = 0u; mine = 0u;
#pragma unroll
        for (unsigned j = 0; j < 16; ++j) { const unsigned c = xb_ld(&bar[XB_XCNT(j)]); sum += c; cnt += (c > 0u) ? 1u : 0u; mine = (j == x) ? c : mine; }
        if (sum == G) break;
        __builtin_amdgcn_s_sleep(1);
        if ((++sp & 255u) == 0u) { if (xb_ld(&bar[XB_TMO])) break; if (sp > XB_SPIN_CAP) { atomicAdd(&bar[XB_TMO], 1u); break; } }
    }
    nloc = mine > 0u ? mine : 1u; nx = cnt > 0u ? cnt : 1u;
}

__device__ __forceinline__ void xcd_barrier(const XcdBarrier& b) {
    asm volatile("s_waitcnt vmcnt(0)" ::: "memory");
    __syncthreads();
    if (threadIdx.x == 0) {
        unsigned* bar = b.bar;
        __builtin_amdgcn_s_waitcnt(0);
        unsigned nloc = b.st[0], nx = b.st[1];
        if (nloc == 0u) { xcd_barrier_complete(bar, b.x, nloc, nx); b.st[0] = nloc; b.st[1] = nx; }
        const unsigned old = xb_add(&bar[XB_XSUB(b.x)], 1u);
        const unsigned gen = old / nloc;
        if (old + 1u == (gen + 1u) * nloc) {
            __builtin_amdgcn_fence(__ATOMIC_RELEASE, "agent");
            asm volatile("s_waitcnt vmcnt(0)" ::: "memory");
            const unsigned og = xb_add(&bar[XB_TOP], 1u);
            const unsigned tg = og / nx;
            if (og + 1u == (tg + 1u) * nx) xb_add(&bar[XB_TOPGEN], 1u);
            else XB_SPIN(xb_ld(&bar[XB_TOPGEN]) == tg, bar);
            __builtin_amdgcn_fence(__ATOMIC_ACQUIRE, "agent");
            xb_add(&bar[XB_XGEN(b.x)], 1u);
            asm volatile("s_waitcnt vmcnt(0)" ::: "memory");
        } else {
            XB_SPIN(xb_ld(&bar[XB_XGEN(b.x)]) == gen, bar);
            __builtin_amdgcn_fence(__ATOMIC_ACQUIRE, "agent");
            asm volatile("s_waitcnt vmcnt(0)" ::: "memory");
        }
    }
    __syncthreads();
}

namespace pg8 {
constexpr int BM = 256, BK = 64, HALF = 128, HTB = HALF * BK * 2, STAGE_BYTES = 8 * HTB, NXCD = 8, WGM = 4;
__device__ __forceinline__ int lds_byte(int r, int c) { const int st = (r >> 4) * 2 + (c >> 5), rr = r & 15, cc = c & 31, ob = rr * 64 + cc * 2; return st * 1024 + (ob ^ (((ob >> 9) & 1) << 5)); }
__device__ __forceinline__ void stage_rc(int b, int& R, int& C) { const int st = b / 1024, sb = b % 1024, swz = sb ^ (((sb >> 9) & 1) << 5); R = (st >> 1) * 16 + swz / 64; C = (st & 1) * 32 + (swz % 64) / 2; }
__device__ __forceinline__ int perm32(int rho) { const int n = rho >> 4, i = rho & 15; return 8 * (i >> 2) + 4 * n + (i & 3); }
struct Unit { int pm, pn, aux, nt; const char* A; const char* B; };
__device__ __forceinline__ void tile_map(int L, int nM, int nN, int& pm, int& pn) {
    const int nwg = nM * nN; int wgid = L;
    { const int q = nwg / NXCD, r = nwg % NXCD, xcd = wgid % NXCD, off = wgid / NXCD; wgid = (xcd < r ? xcd * (q + 1) : r * (q + 1) + (xcd - r) * q) + off; }
    const int nig = WGM * nN, gid = wgid / nig, fm = gid * WGM, gsz = (nM - fm) < WGM ? (nM - fm) : WGM;
    pm = fm + ((wgid % nig) % gsz); pn = (wgid % nig) / gsz;
}
template <class Epi, class Sched>
__device__ __forceinline__ void gemm_phase(LAS unsigned char* lds, const int lda, const int ldb, const Sched& S, const Epi& E) {
    int tid = threadIdx.x; asm volatile("" : "+v"(tid));
    const int wid = __builtin_amdgcn_readfirstlane(tid >> 6), lane = tid & 63, wr = wid >> 2, wc = wid & 3, fr = lane & 15, fq = lane >> 4;
    unsigned voffA[2], voffB[2];
#pragma unroll
    for (int i = 0; i < 2; ++i) { int R, C; stage_rc(tid * 16 + i * 8192, R, C); const int Rb = Epi::PERM ? ((R & ~31) + perm32(R & 31)) : R;
        voffA[i] = (unsigned)(R * lda + C) * 2u; voffB[i] = (unsigned)(Rb * ldb + C) * 2u; }
    const size_t kstep = (size_t)(BK * 2);
    const size_t hstepA = (size_t)HALF * lda * 2, hstepB = (size_t)HALF * ldb * 2;
    const unsigned ldsw = (unsigned)wid * 1024u;
    const int aoff = lds_byte(wr * 64 + fr, fq * 8), boff = lds_byte(wc * 32 + fr, fq * 8);
#define PG8_SA(b, h) (((b) * 2 + (h)) * HTB)
#define PG8_SB(b, h) ((4 + (b) * 2 + (h)) * HTB)
#define PG8_STAGE(bufoff, gbase, voff) do { _Pragma("unroll") for (int _i = 0; _i < 2; ++_i) \
        __builtin_amdgcn_global_load_lds((const unsigned*)((const char*)(gbase) + (voff)[_i]), (LAS unsigned*)(lds + (bufoff) + ldsw + _i * 8192), 16, 0, 0); } while (0)
#define PG8_LDA(dst, b, h) do { _Pragma("unroll") for (int m = 0; m < 4; ++m) _Pragma("unroll") for (int k = 0; k < 2; ++k) dst[m][k] = *(const LAS bf16x8*)(lds + PG8_SA(b, h) + aoff + m * 2048 + k * 1024); } while (0)
#define PG8_LDB(dst, b, h) do { _Pragma("unroll") for (int n = 0; n < 2; ++n) _Pragma("unroll") for (int k = 0; k < 2; ++k) dst[n][k] = *(const LAS bf16x8*)(lds + PG8_SB(b, h) + boff + n * 2048 + k * 1024); } while (0)
#define PG8_MMA(ai, bj, At, Bt) do { __builtin_amdgcn_s_setprio(1); _Pragma("unroll") for (int m = 0; m < 4; ++m) _Pragma("unroll") for (int n = 0; n < 2; ++n) _Pragma("unroll") for (int k = 0; k < 2; ++k) \
        acc[ai][bj][m][n] = __builtin_amdgcn_mfma_f32_16x16x32_bf16(Bt[n][k], At[m][k], acc[ai][bj][m][n], 0, 0, 0); __builtin_amdgcn_s_setprio(0); } while (0)
#define PG8_WAIT_V(n) asm volatile("s_waitcnt vmcnt(" #n ")" ::: "memory")
#define PG8_WAIT_L(n) asm volatile("s_waitcnt lgkmcnt(" #n ")" ::: "memory")
#define PG8_BAR __builtin_amdgcn_s_barrier()
#define PG8_SCHED __builtin_amdgcn_sched_barrier(0)
    Unit cur, nxt; int ui = 0;
    if (!S.next(0, cur)) return;
    f32x4 acc[2][2][4][2];
#pragma unroll
    for (int a = 0; a < 2; ++a)
#pragma unroll
        for (int b = 0; b < 2; ++b)
#pragma unroll
            for (int m = 0; m < 4; ++m)
#pragma unroll
                for (int n = 0; n < 2; ++n) acc[a][b][m][n] = (f32x4){0.f, 0.f, 0.f, 0.f};
    bf16x8 At[4][2], B0[2][2], B1[2][2];
    const char* cA = cur.A; const char* cB = cur.B;
    PG8_STAGE(PG8_SB(0, 0), cB, voffB); PG8_STAGE(PG8_SA(0, 0), cA, voffA); PG8_STAGE(PG8_SB(0, 1), cB + hstepB, voffB); PG8_STAGE(PG8_SA(0, 1), cA + hstepA, voffA);
    if (wr == 1) PG8_BAR;
    PG8_WAIT_V(4); PG8_BAR;
    PG8_STAGE(PG8_SB(1, 0), cB + kstep, voffB); PG8_STAGE(PG8_SA(1, 0), cA + kstep, voffA); PG8_STAGE(PG8_SB(1, 1), cB + hstepB + kstep, voffB);
    PG8_WAIT_V(6); PG8_BAR;
    for (;;) {
        const bool has_next = S.next(ui + 1, nxt);
        const char* nA = has_next ? nxt.A : cA; const char* nB = has_next ? nxt.B : cB;
        const int nt = cur.nt;
        for (int t = 0; t < nt; t += 2) {
            const bool last = (t == nt - 2);
            const char* a1 = cA + (size_t)(t + 1) * kstep;
            const char* a2 = last ? nA : cA + (size_t)(t + 2) * kstep; const char* b2 = last ? nB : cB + (size_t)(t + 2) * kstep;
            const char* a3 = a2 + kstep; const char* b3 = b2 + kstep;
            PG8_LDB(B0, 0, 0); PG8_SCHED; PG8_LDA(At, 0, 0); PG8_STAGE(PG8_SA(1, 1), a1 + hstepA, voffA);
            PG8_WAIT_L(8); PG8_BAR; PG8_WAIT_L(0); PG8_MMA(0, 0, At, B0); PG8_BAR; PG8_SCHED;
            PG8_LDB(B1, 0, 1); PG8_STAGE(PG8_SB(0, 0), b2, voffB);
            PG8_BAR; PG8_WAIT_L(0); PG8_MMA(0, 1, At, B1); PG8_BAR;
            PG8_LDA(At, 0, 1); PG8_STAGE(PG8_SA(0, 0), a2, voffA);
            PG8_BAR; PG8_WAIT_L(0); PG8_MMA(1, 0, At, B0); PG8_BAR; PG8_SCHED;
            PG8_STAGE(PG8_SB(0, 1), b2 + hstepB, voffB);
            PG8_WAIT_V(6); PG8_BAR; PG8_MMA(1, 1, At, B1); PG8_BAR;
            PG8_LDB(B0, 1, 0); PG8_SCHED; PG8_LDA(At, 1, 0); PG8_STAGE(PG8_SA(0, 1), a2 + hstepA, voffA);
            PG8_WAIT_L(8); PG8_BAR; PG8_WAIT_L(0); PG8_MMA(0, 0, At, B0); PG8_BAR; PG8_SCHED;
            PG8_LDB(B1, 1, 1); PG8_STAGE(PG8_SB(1, 0), b3, voffB);
            PG8_BAR; PG8_WAIT_L(0); PG8_MMA(0, 1, At, B1); PG8_BAR;
            PG8_LDA(At, 1, 1); PG8_STAGE(PG8_SA(1, 0), a3, voffA);
            PG8_BAR; PG8_WAIT_L(0); PG8_MMA(1, 0, At, B0); PG8_BAR; PG8_SCHED;
            PG8_STAGE(PG8_SB(1, 1), b3 + hstepB, voffB);
            PG8_WAIT_V(6); PG8_BAR; PG8_MMA(1, 1, At, B1); PG8_BAR;
        }
        E(acc, cur, wr, wc, fr, fq);
        if (!has_next) break;
#pragma unroll
        for (int a = 0; a < 2; ++a)
#pragma unroll
            for (int b = 0; b < 2; ++b)
#pragma unroll
                for (int m = 0; m < 4; ++m)
#pragma unroll
                    for (int n = 0; n < 2; ++n) acc[a][b][m][n] = (f32x4){0.f, 0.f, 0.f, 0.f};
        cur = nxt; cA = nA; cB = nB; ++ui;
    }
    PG8_WAIT_V(0);
    if (wr == 0) PG8_BAR;
    PG8_BAR;
#undef PG8_SA
#undef PG8_SB
#undef PG8_STAGE
#undef PG8_LDA
#undef PG8_LDB
#undef PG8_MMA
#undef PG8_WAIT_V
#undef PG8_WAIT_L
#undef PG8_BAR
#undef PG8_SCHED
}
}
using pg8::Unit;

struct SchedPlain {
    const char* A; const char* B; size_t astep, bstep; int nM, nN, nt, G, c, skip;
    __device__ __forceinline__ bool next(int i, Unit& u) const {
        const long L = (long)i * G + c; if (L >= (long)nM * nN) return false;
        pg8::tile_map((int)L, nM, nN, u.pm, u.pn); if (skip) u.pm += (u.pm >> 3) + 1; u.A = A + (size_t)u.pm * astep; u.B = B + (size_t)u.pn * bstep; u.nt = nt; u.aux = 0; return true;
    }
};
struct SchedBranch {
    const char* A; const char* B; int G, c, nM, skip;
    __device__ __forceinline__ bool next(int i, Unit& u) const {
        const long L = (long)i * G + c; if (L >= 3 * nM * 4) return false;
        const int b = (int)(L / (nM * 4)), rem = (int)(L % (nM * 4));
        pg8::tile_map(rem, nM, 4, u.pm, u.pn); if (skip) u.pm += (u.pm >> 3) + 1;
        const int koff = b == 0 ? 0 : (b == 1 ? 256 : 640);
        u.A = A + ((size_t)u.pm * 256 * 1024 + koff) * 2; u.B = B + ((size_t)u.pn * 256 * 1024 + koff) * 2; u.nt = b == 0 ? 4 : 6; u.aux = b; return true;
    }
};
struct SchedGate {
    const char* A; const char* B; int G, c, nM, skip;
    __device__ __forceinline__ bool next(int i, Unit& u) const {
        const int j = i / 3, b = i - 3 * j; const long L = (long)j * G + c; if (L >= nM * 4) return false;
        pg8::tile_map((int)L, nM, 4, u.pm, u.pn); if (skip) u.pm += (u.pm >> 3) + 1;
        u.A = A + (size_t)u.pm * 256 * 1024 * 2; u.B = B + (size_t)(b * 4 + u.pn) * 256 * 1024 * 2; u.nt = 16; u.aux = b; return true;
    }
};
struct SchedMerge {
    const char* Y; const char* Wbr; const char* XN; const char* Wg; int G, c, nM, skip;
    __device__ __forceinline__ bool next(int i, Unit& u) const {
        const int j = i / 6, sub = i - 6 * j, b = sub >> 1, kind = sub & 1; const long L = (long)j * G + c; if (L >= nM * 4) return false;
        pg8::tile_map((int)L, nM, 4, u.pm, u.pn); if (skip) u.pm += (u.pm >> 3) + 1;
        u.aux = sub;
        if (kind == 0) { const int koff = b == 0 ? 0 : (b == 1 ? 256 : 640);
            u.A = Y + ((size_t)u.pm * 256 * 1024 + koff) * 2; u.B = Wbr + ((size_t)u.pn * 256 * 1024 + koff) * 2; u.nt = b == 0 ? 4 : 6; }
        else { u.A = XN + (size_t)u.pm * 256 * 1024 * 2; u.B = Wg + (size_t)(b * 4 + u.pn) * 256 * 1024 * 2; u.nt = 16; }
        return true;
    }
};
struct SchedInProjLast {
    const char* A; const char* B; int G, c;
    __device__ __forceinline__ bool next(int i, Unit& u) const {
        const long L = (long)i * G + c; if (L >= 256 * 11 + 32 * 8) return false;
        if (L < 256 * 11) { pg8::tile_map((int)L, 256, 11, u.pm, u.pn); u.pm += (u.pm >> 3) + 1; }
        else { const int idx = (int)L - 256 * 11, b = idx >> 3, j = idx & 7; u.pm = 9 * b; u.pn = j < 4 ? j : (j < 7 ? j + 2 : 10); }
        u.A = A + (size_t)u.pm * 256 * 1024 * 2; u.B = B + (size_t)u.pn * 256 * 1024 * 2; u.nt = 16; u.aux = 0; return true;
    }
};
struct SchedS5 {
    const char* A; const char* B; int nN, ldb, nt, G, c;
    __device__ __forceinline__ bool next(int i, Unit& u) const {
        const long L = (long)i * G + c; if (L >= 16 * 9 * nN) return false;
        const int g = (int)L / (9 * nN), rem = (int)L % (9 * nN); u.pm = rem / nN; u.pn = rem % nN; u.aux = g;
        u.A = A + ((size_t)g * 2304 + u.pm * 256) * 768 * 2; u.B = B + ((size_t)g * nN * 256 + u.pn * 256) * ldb * 2; u.nt = nt; return true;
    }
};

#define EPI_ARGS const f32x4 (&acc)[2][2][4][2], const Unit& u, int wr, int wc, int fr, int fq
__device__ __forceinline__ u32x4 pack8(const f32x4 a, const f32x4 b) { u32x4 w; w.x = pk2(a[0], a[1]); w.y = pk2(a[2], a[3]); w.z = pk2(b[0], b[1]); w.w = pk2(b[2], b[3]); return w; }

struct EpiInProj {
    static constexpr bool PERM = true;
    bf16_t* PM; bf16_t* UH;
    __device__ __forceinline__ void operator()(EPI_ARGS) const {
        const int row0 = u.pm * 256 + wr * 64 + fr, ct0 = wc * 32 + 8 * fq;
#pragma unroll
        for (int ai = 0; ai < 2; ++ai)
#pragma unroll
            for (int m = 0; m < 4; ++m) { const int row = row0 + ai * 128 + m * 16;
#pragma unroll
                for (int bj = 0; bj < 2; ++bj) { const int ct = ct0 + bj * 128; const u32x4 w = pack8(acc[ai][bj][m][0], acc[ai][bj][m][1]);
                    bf16_t* dst = (u.pn == 0) ? UH + ((size_t)(ct >> 4) * 2304 + (row >> 5)) * 768 + (row & 31) * 16 + (ct & 15)
                                              : PM + pm_off((size_t)row, (u.pn - 1) * 256 + ct);
                    *(u32x4*)dst = w; } }
    }
};
struct EpiS5State {
    static constexpr bool PERM = false;
    float* SS;
    __device__ __forceinline__ void operator()(EPI_ARGS) const {
        const int row0 = u.pm * 256 + wr * 64 + fr, col0 = wc * 32 + 4 * fq;
        float* base = SS + (size_t)u.aux * 2304 * 256;
#pragma unroll
        for (int ai = 0; ai < 2; ++ai)
#pragma unroll
            for (int m = 0; m < 4; ++m) { float* rowp = base + (size_t)(row0 + ai * 128 + m * 16) * 256 + col0;
#pragma unroll
                for (int bj = 0; bj < 2; ++bj)
#pragma unroll
                    for (int n = 0; n < 2; ++n) *(f32x4*)(rowp + bj * 128 + n * 16) = acc[ai][bj][m][n]; }
    }
};
struct EpiS5Out {
    static constexpr bool PERM = true;
    bf16_t* Y5;
    __device__ __forceinline__ void operator()(EPI_ARGS) const {
        const int row0 = u.pm * 256 + wr * 64 + fr, ct0 = u.pn * 256 + wc * 32 + 8 * fq, g = u.aux;
#pragma unroll
        for (int ai = 0; ai < 2; ++ai)
#pragma unroll
            for (int m = 0; m < 4; ++m) { const int R = row0 + ai * 128 + m * 16;
#pragma unroll
                for (int bj = 0; bj < 2; ++bj) { const int n = ct0 + bj * 128; const int t = n >> 4, c = n & 15;
                    f32x4 a = acc[ai][bj][m][0], b = acc[ai][bj][m][1];
#pragma unroll
                    for (int j = 0; j < 4; ++j) { a[j] = geluf_(a[j]); b[j] = geluf_(b[j]); }
                    *(u32x4*)(Y5 + ((size_t)R * 32 + t) * 256 + g * 16 + c) = pack8(a, b); } }
    }
};
struct EpiGlu {
    static constexpr bool PERM = true;
    const bf16_t* Y5; bf16_t* Y; const float* gb;
    __device__ __forceinline__ void operator()(EPI_ARGS) const {
        const int row0 = u.pm * 256 + wr * 64 + fr, ct0 = wc * 32 + 8 * fq;
        f32x4 bia[2][2];
#pragma unroll
        for (int bj = 0; bj < 2; ++bj) { bia[bj][0] = *(const f32x4*)(gb + ct0 + bj * 128); bia[bj][1] = *(const f32x4*)(gb + ct0 + bj * 128 + 4); }
#pragma unroll
        for (int ai = 0; ai < 2; ++ai) { u32x4 yv[8];
#pragma unroll
            for (int m = 0; m < 4; ++m)
#pragma unroll
                for (int bj = 0; bj < 2; ++bj) yv[m * 2 + bj] = *(const u32x4*)(Y5 + (size_t)(row0 + ai * 128 + m * 16) * 256 + ct0 + bj * 128);
#pragma unroll
            for (int m = 0; m < 4; ++m)
#pragma unroll
                for (int bj = 0; bj < 2; ++bj) { const int row = row0 + ai * 128 + m * 16, c = ct0 + bj * 128; const u32x4 y4 = yv[m * 2 + bj];
                    f32x4 a = acc[ai][bj][m][0] + bia[bj][0], b = acc[ai][bj][m][1] + bia[bj][1];
                    a[0] = bflo(y4.x) * sigmoidf_(a[0]); a[1] = bfhi(y4.x) * sigmoidf_(a[1]); a[2] = bflo(y4.y) * sigmoidf_(a[2]); a[3] = bfhi(y4.y) * sigmoidf_(a[3]);
                    b[0] = bflo(y4.z) * sigmoidf_(b[0]); b[1] = bfhi(y4.z) * sigmoidf_(b[1]); b[2] = bflo(y4.w) * sigmoidf_(b[2]); b[3] = bfhi(y4.w) * sigmoidf_(b[3]);
                    *(u32x4*)(Y + (size_t)row * 1024 + c) = pack8(a, b); } }
    }
};
struct EpiBranch {
    static constexpr bool PERM = true;
    bf16_t* YB;
    __device__ __forceinline__ void operator()(EPI_ARGS) const {
        const int row0 = u.pm * 256 + wr * 64 + fr, ct0 = u.aux * 1024 + u.pn * 256 + wc * 32 + 8 * fq;
#pragma unroll
        for (int ai = 0; ai < 2; ++ai)
#pragma unroll
            for (int m = 0; m < 4; ++m) { const int row = row0 + ai * 128 + m * 16;
#pragma unroll
                for (int bj = 0; bj < 2; ++bj) *(u32x4*)(YB + (size_t)row * 3072 + ct0 + bj * 128) = pack8(acc[ai][bj][m][0], acc[ai][bj][m][1]); }
    }
};
struct EpiGate {
    static constexpr bool PERM = true;
    const bf16_t* YB; bf16_t* M1;
    __device__ __forceinline__ void operator()(EPI_ARGS) const {
        const int row0 = u.pm * 256 + wr * 64 + fr, ct0 = u.pn * 256 + wc * 32 + 8 * fq, b = u.aux;
#pragma unroll
        for (int ai = 0; ai < 2; ++ai)
#pragma unroll
            for (int m = 0; m < 4; ++m) { const int row = row0 + ai * 128 + m * 16;
#pragma unroll
                for (int bj = 0; bj < 2; ++bj) { const int c = ct0 + bj * 128;
                    const u32x4 yv = *(const u32x4*)(YB + (size_t)row * 3072 + b * 1024 + c);
                    bf16_t* mp = M1 + (size_t)row * 1024 + c;
                    f32x4 p = acc[ai][bj][m][0], q = acc[ai][bj][m][1];
                    p[0] = bflo(yv.x) * sigmoidf_(p[0]); p[1] = bfhi(yv.x) * sigmoidf_(p[1]); p[2] = bflo(yv.y) * sigmoidf_(p[2]); p[3] = bfhi(yv.y) * sigmoidf_(p[3]);
                    q[0] = bflo(yv.z) * sigmoidf_(q[0]); q[1] = bfhi(yv.z) * sigmoidf_(q[1]); q[2] = bflo(yv.w) * sigmoidf_(q[2]); q[3] = bfhi(yv.w) * sigmoidf_(q[3]);
                    if (b != 0) { const u32x4 mv = *(const u32x4*)mp;
                        p[0] += bflo(mv.x); p[1] += bfhi(mv.x); p[2] += bflo(mv.y); p[3] += bfhi(mv.y);
                        q[0] += bflo(mv.z); q[1] += bfhi(mv.z); q[2] += bflo(mv.w); q[3] += bfhi(mv.w); }
                    *(u32x4*)mp = pack8(p, q); } }
    }
};
struct EpiMerge {
    static constexpr bool PERM = true;
    bf16_t* scr; bf16_t* M1;
    __device__ __forceinline__ void operator()(EPI_ARGS) const {
        const int b = u.aux >> 1, kind = u.aux & 1;
        int frl = fr, fql = fq; asm volatile("" : "+v"(frl), "+v"(fql));
        const int rt0 = wr * 64 + frl, ct0 = wc * 32 + 8 * fql;
        bf16_t* s1 = scr + rt0 * 256 + ct0; bf16_t* s2 = s1 + 65536;
        if (kind == 0) {
#pragma unroll
            for (int ai = 0; ai < 2; ++ai)
#pragma unroll
                for (int m = 0; m < 4; ++m)
#pragma unroll
                    for (int bj = 0; bj < 2; ++bj) *(u32x4*)(s1 + (ai * 128 + m * 16) * 256 + bj * 128) = pack8(acc[ai][bj][m][0], acc[ai][bj][m][1]);
        } else {
            bf16_t* dbase; int dld;
            if (b == 2) { dbase = M1 + (size_t)(u.pm * 256 + rt0) * 1024 + u.pn * 256 + ct0; dld = 1024; } else { dbase = s2; dld = 256; }
#pragma unroll
            for (int ai = 0; ai < 2; ++ai) {
                u32x4 yv[8], mvv[8];
#pragma unroll
                for (int m = 0; m < 4; ++m)
#pragma unroll
                    for (int bj = 0; bj < 2; ++bj) { const int off = (ai * 128 + m * 16) * 256 + bj * 128; yv[m * 2 + bj] = *(const u32x4*)(s1 + off);
                        mvv[m * 2 + bj] = (b != 0) ? *(const u32x4*)(s2 + off) : (u32x4){0u, 0u, 0u, 0u}; }
#pragma unroll
                for (int m = 0; m < 4; ++m)
#pragma unroll
                    for (int bj = 0; bj < 2; ++bj) { const int ro = ai * 128 + m * 16; const u32x4 y4 = yv[m * 2 + bj], m4 = mvv[m * 2 + bj];
                        f32x4 p = acc[ai][bj][m][0], q = acc[ai][bj][m][1];
                        p[0] = bflo(y4.x) * sigmoidf_(p[0]) + bflo(m4.x); p[1] = bfhi(y4.x) * sigmoidf_(p[1]) + bfhi(m4.x); p[2] = bflo(y4.y) * sigmoidf_(p[2]) + bflo(m4.y); p[3] = bfhi(y4.y) * sigmoidf_(p[3]) + bfhi(m4.y);
                        q[0] = bflo(y4.z) * sigmoidf_(q[0]) + bflo(m4.z); q[1] = bfhi(y4.z) * sigmoidf_(q[1]) + bfhi(m4.z); q[2] = bflo(y4.w) * sigmoidf_(q[2]) + bflo(m4.w); q[3] = bfhi(y4.w) * sigmoidf_(q[3]) + bfhi(m4.w);
                        *(u32x4*)(dbase + (size_t)ro * dld + bj * 128) = pack8(p, q); }
            }
        }
    }
};
struct EpiResid {
    static constexpr bool PERM = false;
    const float* slat; const float* sctx; float* dlat; float* dctx; const float* mod;
    __device__ __forceinline__ void operator()(EPI_ARGS) const {
        const int b = u.pm / 9, j = u.pm - 9 * b;
        const size_t tbase = (j == 0) ? (size_t)b * 256 * 1024 : ((size_t)b * 2048 + (size_t)(j - 1) * 256) * 1024;
        const int r0 = wr * 64 + fr, col0 = u.pn * 256 + wc * 32 + 4 * fq;
        const float* src = ((j == 0) ? sctx : slat) + tbase + (size_t)r0 * 1024 + col0; float* dst = ((j == 0) ? dctx : dlat) + tbase + (size_t)r0 * 1024 + col0;
        const float* mp = mod + (size_t)((j == 0) ? 32 : b) * 6144 + col0;
        f32x4 mv[2][2];
#pragma unroll
        for (int bj = 0; bj < 2; ++bj)
#pragma unroll
            for (int n = 0; n < 2; ++n) mv[bj][n] = *(const f32x4*)(mp + bj * 128 + n * 16);
        f32x4 xa[8], xb[8];
#define RES_LOAD(buf, g) do { _Pragma("unroll") for (int mm = 0; mm < 2; ++mm) _Pragma("unroll") for (int bj = 0; bj < 2; ++bj) _Pragma("unroll") for (int n = 0; n < 2; ++n) \
            buf[mm * 4 + bj * 2 + n] = *(const f32x4*)(src + (size_t)(((g) >> 1) * 128 + (2 * ((g) & 1) + mm) * 16) * 1024 + bj * 128 + n * 16); } while (0)
#define RES_STORE(buf, g) do { _Pragma("unroll") for (int mm = 0; mm < 2; ++mm) _Pragma("unroll") for (int bj = 0; bj < 2; ++bj) _Pragma("unroll") for (int n = 0; n < 2; ++n) \
            *(f32x4*)(dst + (size_t)(((g) >> 1) * 128 + (2 * ((g) & 1) + mm) * 16) * 1024 + bj * 128 + n * 16) = buf[mm * 4 + bj * 2 + n] + mv[bj][n] * acc[(g) >> 1][bj][2 * ((g) & 1) + mm][n]; } while (0)
        RES_LOAD(xa, 0); RES_LOAD(xb, 1);
        RES_STORE(xa, 0); RES_LOAD(xa, 2);
        RES_STORE(xb, 1); RES_LOAD(xb, 3);
        RES_STORE(xa, 2); RES_STORE(xb, 3);
#undef RES_LOAD
#undef RES_STORE
    }
};
template <bool BSRC> struct EpiResidMid {
    static constexpr bool PERM = false;
    const float* slat; const float* sctx; const bf16_t* xb; bf16_t* xmid; const float* mod;
    __device__ __forceinline__ void operator()(EPI_ARGS) const {
        const int b = u.pm / 9, j = u.pm - 9 * b;
        const size_t tbase = (j == 0) ? (size_t)b * 256 * 1024 : ((size_t)b * 2048 + (size_t)(j - 1) * 256) * 1024;
        const int r0 = wr * 64 + fr, col0 = u.pn * 256 + wc * 32 + 4 * fq;
        const size_t uoff = ((size_t)u.pm * 256 + r0) * 1024 + col0;
        const float* src = ((j == 0) ? sctx : slat) + tbase + (size_t)r0 * 1024 + col0;
        const bf16_t* srcb = xb + uoff;
        bf16_t* dst = xmid + uoff;
        const float* mp = mod + (size_t)((j == 0) ? 32 : b) * 6144 + col0;
        f32x4 mv[2][2];
#pragma unroll
        for (int bj = 0; bj < 2; ++bj)
#pragma unroll
            for (int n = 0; n < 2; ++n) mv[bj][n] = *(const f32x4*)(mp + bj * 128 + n * 16);
        f32x4 xa[8], xb_[8];
#define RES_LOAD(buf, g) do { _Pragma("unroll") for (int mm = 0; mm < 2; ++mm) _Pragma("unroll") for (int bj = 0; bj < 2; ++bj) _Pragma("unroll") for (int n = 0; n < 2; ++n) { \
            const size_t o_ = (size_t)(((g) >> 1) * 128 + (2 * ((g) & 1) + mm) * 16) * 1024 + bj * 128 + n * 16; \
            if (BSRC) { const u32x2 xw = *(const u32x2*)(srcb + o_); buf[mm * 4 + bj * 2 + n] = (f32x4){bflo(xw.x), bfhi(xw.x), bflo(xw.y), bfhi(xw.y)}; } \
            else buf[mm * 4 + bj * 2 + n] = *(const f32x4*)(src + o_); } } while (0)
#define RES_STORE(buf, g) do { _Pragma("unroll") for (int mm = 0; mm < 2; ++mm) _Pragma("unroll") for (int bj = 0; bj < 2; ++bj) _Pragma("unroll") for (int n = 0; n < 2; ++n) { \
            const f32x4 y = buf[mm * 4 + bj * 2 + n] + mv[bj][n] * acc[(g) >> 1][bj][2 * ((g) & 1) + mm][n]; u32x2 w; w.x = pk2(y[0], y[1]); w.y = pk2(y[2], y[3]); \
            *(u32x2*)(dst + (size_t)(((g) >> 1) * 128 + (2 * ((g) & 1) + mm) * 16) * 1024 + bj * 128 + n * 16) = w; } } while (0)
        RES_LOAD(xa, 0); RES_LOAD(xb_, 1);
        RES_STORE(xa, 0); RES_LOAD(xa, 2);
        RES_STORE(xb_, 1); RES_LOAD(xb_, 3);
        RES_STORE(xa, 2); RES_STORE(xb_, 3);
#undef RES_LOAD
#undef RES_STORE
    }
};
template <bool BOUT> struct EpiResidOut {
    static constexpr bool PERM = false;
    const bf16_t* xmid; float* dlat; bf16_t* xb; const float* mod;
    __device__ __forceinline__ void operator()(EPI_ARGS) const {
        const int b = u.pm / 9, j = u.pm - 9 * b;
        const int r0 = wr * 64 + fr, col0 = u.pn * 256 + wc * 32 + 4 * fq;
        const size_t uoff = ((size_t)u.pm * 256 + r0) * 1024 + col0;
        const bf16_t* src = xmid + uoff;
        float* dst = dlat + ((size_t)b * 2048 + (size_t)(j - 1) * 256 + r0) * 1024 + col0;
        bf16_t* dstb = xb + uoff;
        const float* mp = mod + (size_t)((j == 0) ? 32 : b) * 6144 + col0;
        f32x4 mv[2][2];
#pragma unroll
        for (int bj = 0; bj < 2; ++bj)
#pragma unroll
            for (int n = 0; n < 2; ++n) mv[bj][n] = *(const f32x4*)(mp + bj * 128 + n * 16);
        u32x2 xa[16], xc[16];
#define RES_LOAD(buf, h) do { _Pragma("unroll") for (int m = 0; m < 4; ++m) _Pragma("unroll") for (int bj = 0; bj < 2; ++bj) _Pragma("unroll") for (int n = 0; n < 2; ++n) \
            buf[m * 4 + bj * 2 + n] = *(const u32x2*)(src + (size_t)((h) * 128 + m * 16) * 1024 + bj * 128 + n * 16); } while (0)
#define RES_STORE(buf, h) do { _Pragma("unroll") for (int m = 0; m < 4; ++m) _Pragma("unroll") for (int bj = 0; bj < 2; ++bj) _Pragma("unroll") for (int n = 0; n < 2; ++n) { \
            const u32x2 xw = buf[m * 4 + bj * 2 + n]; const f32x4 xo = {bflo(xw.x), bfhi(xw.x), bflo(xw.y), bfhi(xw.y)}; const f32x4 y = xo + mv[bj][n] * acc[h][bj][m][n]; \
            const size_t o_ = (size_t)((h) * 128 + m * 16) * 1024 + bj * 128 + n * 16; \
            if (BOUT) { u32x2 w; w.x = pk2(y[0], y[1]); w.y = pk2(y[2], y[3]); *(u32x2*)(dstb + o_) = w; } else *(f32x4*)(dst + o_) = y; } } while (0)
        RES_LOAD(xa, 0); RES_LOAD(xc, 1);
        RES_STORE(xa, 0); RES_STORE(xc, 1);
#undef RES_LOAD
#undef RES_STORE
    }
};
struct EpiSwiglu {
    static constexpr bool PERM = true;
    bf16_t* H;
    __device__ __forceinline__ void operator()(EPI_ARGS) const {
        const int row0 = u.pm * 256 + wr * 64 + fr, c0 = u.pn * 128 + wc * 32 + 8 * fq;
#pragma unroll
        for (int ai = 0; ai < 2; ++ai)
#pragma unroll
            for (int m = 0; m < 4; ++m) { const int row = row0 + ai * 128 + m * 16;
                f32x4 a = acc[ai][0][m][0], b = acc[ai][0][m][1]; const f32x4 a2 = acc[ai][1][m][0], b2 = acc[ai][1][m][1];
#pragma unroll
                for (int j = 0; j < 4; ++j) { a[j] = siluf_(a[j]) * a2[j]; b[j] = siluf_(b[j]) * b2[j]; }
                *(u32x4*)(H + (size_t)row * FFH + c0) = pack8(a, b); }
    }
};

struct Params { const float* in[31]; float* out; unsigned char* ws; };

__device__ __forceinline__ void xpose_item(const float* W, int ldsrc, int k0, int c0, bf16_t* dst, int lddst, int r0, float scale, LAS float* scr, int lane) {
    float wv[32];
#pragma unroll
    for (int i = 0; i < 32; ++i) wv[i] = W[(size_t)(k0 + 2 * i + (lane >> 5)) * ldsrc + c0 + (lane & 31)];
#pragma unroll
    for (int i = 0; i < 32; ++i) scr[(2 * i + (lane >> 5)) * 33 + (lane & 31)] = wv[i];
    LDS_WAIT();
    const int c = lane & 7;
#pragma unroll
    for (int j = 0; j < 4; ++j) { const int n = (lane >> 3) + 8 * j; const LAS float* s = scr + (8 * c) * 33 + n;
        u32x4 o; o.x = pk2(s[0] * scale, s[33] * scale); o.y = pk2(s[2 * 33] * scale, s[3 * 33] * scale); o.z = pk2(s[4 * 33] * scale, s[5 * 33] * scale); o.w = pk2(s[6 * 33] * scale, s[7 * 33] * scale);
        *(u32x4*)(dst + (size_t)(r0 + n) * lddst + k0 + 8 * c) = o; }
    LDS_WAIT();
}
__device__ __forceinline__ void xpose_job(const float* W, int ldsrc, int K, int ncols, int srccol0, bf16_t* dst, int lddst, int dstrow0, float scale, int mode, int gw, int NGW, LAS float* scr, int lane) {
    const int nblk = ncols / 32, items = (K / 64) * nblk;
    for (int it = gw; it < items; it += NGW) { const int kb = it / nblk, nb = it - kb * nblk; int r0 = dstrow0 + 32 * nb, c0 = srccol0 + 32 * nb;
        if (mode == 1) { const int pn = r0 >> 8, within = r0 & 255; c0 = within < 128 ? 128 * pn + within : FFH + 128 * pn + within - 128; }
        xpose_item(W, ldsrc, 64 * kb, c0, dst, lddst, r0, scale, scr, lane); }
}

__device__ __forceinline__ void norm_mod_phase(const float* slat, const float* sctx, const float* gain, const float* modl, int ks, bf16_t* XN, int blk, int NGW, int skip) {
    const int tid = fresh_tid(), lane = tid & 63, gw = blk * 8 + __builtin_amdgcn_readfirstlane(tid >> 6);
    const int nrows = skip ? NB * SEQ : MROWS;
    for (int rowb = gw; rowb < nrows; rowb += 4 * NGW) {
        f32x4 v[4][4]; float ss[4];
#pragma unroll
        for (int q = 0; q < 4; ++q) { const int rr = rowb + q * NGW; const int row = skip ? (rr >> 11) * TOK + CTXL + (rr & 2047) : rr; const int b = row / TOK, pos = row - b * TOK;
            const float* src = pos < CTXL ? sctx + ((size_t)b * CTXL + pos) * D : slat + ((size_t)b * SEQ + pos - CTXL) * D;
#pragma unroll
            for (int j = 0; j < 4; ++j) v[q][j] = ((const f32x4*)src)[lane + 64 * j]; }
#pragma unroll
        for (int q = 0; q < 4; ++q) { float a = 0.f;
#pragma unroll
            for (int j = 0; j < 4; ++j) a += v[q][j][0] * v[q][j][0] + v[q][j][1] * v[q][j][1] + v[q][j][2] * v[q][j][2] + v[q][j][3] * v[q][j][3];
            ss[q] = a; }
#pragma unroll
        for (int o = 1; o < 64; o <<= 1) {
#pragma unroll
            for (int q = 0; q < 4; ++q) ss[q] += __shfl_xor(ss[q], o); }
#pragma unroll
        for (int q = 0; q < 4; ++q) { const int rr = rowb + q * NGW; const int row = skip ? (rr >> 11) * TOK + CTXL + (rr & 2047) : rr; const int b = row / TOK, pos = row - b * TOK;
            const float* sh = modl + (size_t)(pos < CTXL ? 32 : b) * 6144 + ks * 1024; const float* sc = sh + 1024;
            const float rstd = rsqrtf(ss[q] * (1.0f / D) + EPS);
#pragma unroll
            for (int j = 0; j < 4; ++j) { const int col = 4 * (lane + 64 * j);
                const f32x4 g4 = *(const f32x4*)(gain + col), s4 = *(const f32x4*)(sc + col), h4 = *(const f32x4*)(sh + col);
                f32x4 y;
#pragma unroll
                for (int e = 0; e < 4; ++e) y[e] = v[q][j][e] * rstd * g4[e] * (1.0f + s4[e]) + h4[e];
                u32x2 w; w.x = pk2(y[0], y[1]); w.y = pk2(y[2], y[3]);
                *(u32x2*)(XN + (size_t)row * D + col) = w; } }
    }
}
__device__ __forceinline__ void norm_mod_mid_phase(const bf16_t* xmid, const float* gain, const float* modl, int ks, bf16_t* XN, int blk, int NGW, int skip) {
    const int tid = fresh_tid(), lane = tid & 63, gw = blk * 8 + __builtin_amdgcn_readfirstlane(tid >> 6);
    const int nrows = skip ? NB * SEQ : MROWS;
    for (int rowb = gw; rowb < nrows; rowb += 4 * NGW) {
        u32x4 v[4][2]; float ss[4];
#pragma unroll
        for (int q = 0; q < 4; ++q) { const int rr = rowb + q * NGW; const int row = skip ? (rr >> 11) * TOK + CTXL + (rr & 2047) : rr;
            const bf16_t* src = xmid + (size_t)row * D + 8 * lane; v[q][0] = *(const u32x4*)src; v[q][1] = *(const u32x4*)(src + 512); }
#pragma unroll
        for (int q = 0; q < 4; ++q) { float a = 0.f;
#pragma unroll
            for (int j = 0; j < 2; ++j) { float f[8]; unpack8(v[q][j], f);
#pragma unroll
                for (int e = 0; e < 8; ++e) a += f[e] * f[e]; }
            ss[q] = a; }
#pragma unroll
        for (int o = 1; o < 64; o <<= 1) {
#pragma unroll
            for (int q = 0; q < 4; ++q) ss[q] += __shfl_xor(ss[q], o); }
#pragma unroll
        for (int q = 0; q < 4; ++q) { const int rr = rowb + q * NGW; const int row = skip ? (rr >> 11) * TOK + CTXL + (rr & 2047) : rr; const int b = row / TOK, pos = row - b * TOK;
            const float* sh = modl + (size_t)(pos < CTXL ? 32 : b) * 6144 + ks * 1024; const float* sc = sh + 1024;
            const float rstd = rsqrtf(ss[q] * (1.0f / D) + EPS);
#pragma unroll
            for (int j = 0; j < 2; ++j) { const int col = 8 * lane + 512 * j; float f[8]; unpack8(v[q][j], f);
                const f32x4 g0 = *(const f32x4*)(gain + col), g1 = *(const f32x4*)(gain + col + 4), s0 = *(const f32x4*)(sc + col), s1 = *(const f32x4*)(sc + col + 4), h0 = *(const f32x4*)(sh + col), h1 = *(const f32x4*)(sh + col + 4);
                f32x4 y0, y1;
#pragma unroll
                for (int e = 0; e < 4; ++e) { y0[e] = f[e] * rstd * g0[e] * (1.0f + s0[e]) + h0[e]; y1[e] = f[4 + e] * rstd * g1[e] * (1.0f + s1[e]) + h1[e]; }
                *(u32x4*)(XN + (size_t)row * D + col) = pack8(y0, y1); } }
    }
}
__device__ __forceinline__ void final_norm_phase(float* xl, const float* gain, int blk, int NGW) {
    const int tid = fresh_tid(), lane = tid & 63, gw = blk * 8 + __builtin_amdgcn_readfirstlane(tid >> 6);
    f32x4 g4[4];
#pragma unroll
    for (int j = 0; j < 4; ++j) g4[j] = *(const f32x4*)(gain + 4 * (lane + 64 * j));
    for (int rowb = gw; rowb < NB * SEQ; rowb += 4 * NGW) {
        f32x4 v[4][4]; float ss[4];
#pragma unroll
        for (int q = 0; q < 4; ++q) { const float* p = xl + (size_t)(rowb + q * NGW) * D;
#pragma unroll
            for (int j = 0; j < 4; ++j) v[q][j] = ((const f32x4*)p)[lane + 64 * j]; }
#pragma unroll
        for (int q = 0; q < 4; ++q) { float a = 0.f;
#pragma unroll
            for (int j = 0; j < 4; ++j) a += v[q][j][0] * v[q][j][0] + v[q][j][1] * v[q][j][1] + v[q][j][2] * v[q][j][2] + v[q][j][3] * v[q][j][3];
            ss[q] = a; }
#pragma unroll
        for (int o = 1; o < 64; o <<= 1) {
#pragma unroll
            for (int q = 0; q < 4; ++q) ss[q] += __shfl_xor(ss[q], o); }
#pragma unroll
        for (int q = 0; q < 4; ++q) { float* p = xl + (size_t)(rowb + q * NGW) * D; const float rstd = rsqrtf(ss[q] * (1.0f / D) + EPS);
#pragma unroll
            for (int j = 0; j < 4; ++j) ((f32x4*)p)[lane + 64 * j] = v[q][j] * rstd * g4[j]; }
    }
}

struct MixP { const bf16_t* PM; bf16_t* ST; float* DEC; bf16_t* Y; const float* rope; const float* ret_ld; const float* ret_gn; const float* gw; const float* gb; const float* gnorm; };

__device__ __forceinline__ bf16x8 ldsfrag(const LAS bf16_t* p) { return *(const LAS bf16x8*)p; }

__device__ __forceinline__ float dpp_add_(float v, const int ctrl_dummy) { return v; }
#define DPP_STEP(v, ctrl, rmask) v += __builtin_bit_cast(float, __builtin_amdgcn_update_dpp(0, __builtin_bit_cast(int, v), ctrl, rmask, 0xf, false))
__device__ __forceinline__ float wave_incl_scan(float v) {
    DPP_STEP(v, 0x111, 0xf); DPP_STEP(v, 0x112, 0xf); DPP_STEP(v, 0x114, 0xf); DPP_STEP(v, 0x118, 0xf);
    DPP_STEP(v, 0x142, 0xa); DPP_STEP(v, 0x143, 0xc);
    return v;
}
template <int MX> __device__ __forceinline__ void gate_scan(const MixP& P, int h, int d, int kap0, const float (&z)[16], int lane, float (&E)[8], float (&tot)[8]) {
    if constexpr (MX == 0) {
        const float lg = P.ret_ld[d * 4 + h]; const float Ev = lg * (float)(d == 0 ? 63 - lane : lane), tv = 64.0f * lg;
#pragma unroll
        for (int e = 0; e < 8; ++e) { E[e] = Ev; tot[e] = tv; }
    } else {
        const float* w = P.gw + (size_t)d * 16 * 192 + h * 48 + kap0; const float* bb = P.gb + d * 192 + h * 48 + kap0;
#pragma unroll
        for (int e = 0; e < 8; ++e) { float pre = bb[e];
#pragma unroll
            for (int r = 0; r < 16; ++r) pre += z[r] * w[r * 192 + e];
            const float sp = fmaxf(-pre, 0.f) + __logf(1.0f + __expf(-fabsf(pre)));
            const float g = -sp * (1.0f / 16.0f);
            const float p = wave_incl_scan(g);
            tot[e] = __builtin_bit_cast(float, __builtin_amdgcn_readlane(__builtin_bit_cast(int, p), 63));
            E[e] = (d == 0) ? tot[e] - p : p - g; }
    }
}
__device__ __forceinline__ void load_z(const MixP& P, int mx, size_t rowtok, int d, float (&z)[16]) {
    if (mx == 1) { const u32x4 a = *(const u32x4*)(P.PM + pm_off(rowtok, 2304 + 16 * d)), b = *(const u32x4*)(P.PM + pm_off(rowtok, 2304 + 16 * d + 8));
        float t0[8], t1[8]; unpack8(a, t0); unpack8(b, t1);
#pragma unroll
        for (int r = 0; r < 8; ++r) { z[r] = t0[r]; z[8 + r] = t1[r]; }
    } else {
#pragma unroll
        for (int r = 0; r < 16; ++r) z[r] = 0.f;
    }
}
__device__ __forceinline__ void rope8(const MixP& P, int tpos, int kap0, float (&v)[8]) {
    const float* t = P.rope + ((size_t)tpos * 24 + (kap0 >> 1)) * 2;
    const f32x4 cs0 = *(const f32x4*)t, cs1 = *(const f32x4*)(t + 4);
    float a, b;
    a = v[0]; b = v[1]; v[0] = a * cs0[0] - b * cs0[1]; v[1] = a * cs0[1] + b * cs0[0];
    a = v[2]; b = v[3]; v[2] = a * cs0[2] - b * cs0[3]; v[3] = a * cs0[3] + b * cs0[2];
    a = v[4]; b = v[5]; v[4] = a * cs1[0] - b * cs1[1]; v[5] = a * cs1[1] + b * cs1[0];
    a = v[6]; b = v[7]; v[6] = a * cs1[2] - b * cs1[3]; v[7] = a * cs1[3] + b * cs1[2];
}
struct ItemId { int mx, hp, b, c; size_t row0; };
__device__ __forceinline__ ItemId item_decode(int it) { ItemId I; I.mx = it / 2304; const int r = it - I.mx * 2304, bc = r >> 1; I.hp = r & 1; I.b = bc / 36; I.c = bc - 36 * I.b; I.row0 = (size_t)I.b * TOK + I.c * 64; return I; }
__device__ __forceinline__ int next_item(int it, int G, int skip) {
    while (it < 4608 && skip) { const int r = it % 2304, c = (r >> 1) % 36; if (c >= 4) break; it += G; }
    return it;
}
__device__ __forceinline__ void rope8r(const f32x4 cs0, const f32x4 cs1, float (&v)[8]) {
    float a, b;
    a = v[0]; b = v[1]; v[0] = a * cs0[0] - b * cs0[1]; v[1] = a * cs0[1] + b * cs0[0];
    a = v[2]; b = v[3]; v[2] = a * cs0[2] - b * cs0[3]; v[3] = a * cs0[3] + b * cs0[2];
    a = v[4]; b = v[5]; v[4] = a * cs1[0] - b * cs1[1]; v[5] = a * cs1[1] + b * cs1[0];
    a = v[6]; b = v[7]; v[6] = a * cs1[2] - b * cs1[3]; v[7] = a * cs1[3] + b * cs1[2];
}
__device__ __forceinline__ void vT_write(const u32x4 (&v)[3], LAS bf16_t* vT, int wid, int lane) {
#pragma unroll
    for (int pass = 0; pass < 3; ++pass) { const int grp = pass * 8 + wid, h2 = grp / 12, dv0 = (grp - 12 * h2) * 8; const u32x4 w = v[pass];
        LAS bf16_t* o = vT + (h2 * 96 + dv0) * 72 + lane;
        o[0 * 72] = (bf16_t)(w.x & 0xffff); o[1 * 72] = (bf16_t)(w.x >> 16); o[2 * 72] = (bf16_t)(w.y & 0xffff); o[3 * 72] = (bf16_t)(w.y >> 16);
        o[4 * 72] = (bf16_t)(w.z & 0xffff); o[5 * 72] = (bf16_t)(w.z >> 16); o[6 * 72] = (bf16_t)(w.w & 0xffff); o[7 * 72] = (bf16_t)(w.w >> 16); }
}
struct StRegs { u32x4 v[6]; u32x4 z[2]; u32x4 k[6]; };
__device__ __forceinline__ void state_load(const MixP& P, int mx, int b, int c, StRegs& R, int wid, int lane) {
    const int voff = mx ? 1536 : 384, koff = mx ? 1344 : 192;
    const size_t rowt = (size_t)b * TOK + c * 64 + lane;
#pragma unroll
    for (int pass = 0; pass < 6; ++pass) { const int grp = pass * 8 + wid; R.v[pass] = *(const u32x4*)(P.PM + pm_off(rowt, voff + grp * 8)); }
    const int h = wid >> 1, d = wid & 1;
    if (mx == 1) { R.z[0] = *(const u32x4*)(P.PM + pm_off(rowt, 2304 + 16 * d)); R.z[1] = *(const u32x4*)(P.PM + pm_off(rowt, 2304 + 16 * d + 8)); }
    else { R.z[0] = (u32x4){0u, 0u, 0u, 0u}; R.z[1] = (u32x4){0u, 0u, 0u, 0u}; }
#pragma unroll
    for (int grp = 0; grp < 6; ++grp) R.k[grp] = *(const u32x4*)(P.PM + pm_off(rowt, koff + h * 48 + 8 * grp));
}
template <int MX> __device__ __forceinline__ void state_write(const MixP& P, int b, int c, const StRegs& R, LAS bf16_t* vT, LAS bf16_t* KHT, bf16_t* EX, int wid, int lane) {
    const int h = wid >> 1, d = wid & 1;
    const size_t rowt = (size_t)b * TOK + c * 64 + lane;
#pragma unroll
    for (int pass = 0; pass < 6; ++pass) { const int grp = pass * 8 + wid; const u32x4 w = R.v[pass];
        LAS bf16_t* o = vT + (grp * 8) * 72 + lane;
        o[0 * 72] = (bf16_t)(w.x & 0xffff); o[1 * 72] = (bf16_t)(w.x >> 16); o[2 * 72] = (bf16_t)(w.y & 0xffff); o[3 * 72] = (bf16_t)(w.y >> 16);
        o[4 * 72] = (bf16_t)(w.z & 0xffff); o[5 * 72] = (bf16_t)(w.z >> 16); o[6 * 72] = (bf16_t)(w.w & 0xffff); o[7 * 72] = (bf16_t)(w.w >> 16); }
    float z[16];
    { float t0[8], t1[8]; unpack8(R.z[0], t0); unpack8(R.z[1], t1);
#pragma unroll
      for (int r = 0; r < 8; ++r) { z[r] = t0[r]; z[8 + r] = t1[r]; } }
    f32x4 rp[6][2];
#pragma unroll
    for (int grp = 0; grp < 6; ++grp) {
        if (MX == 0 && c >= 4) { const float* t = P.rope + ((size_t)((c - 4) * 64 + lane) * 24 + 4 * grp) * 2; rp[grp][0] = *(const f32x4*)t; rp[grp][1] = *(const f32x4*)(t + 4); }
        else { rp[grp][0] = (f32x4){1.f, 0.f, 1.f, 0.f}; rp[grp][1] = (f32x4){1.f, 0.f, 1.f, 0.f}; } }
#pragma unroll
    for (int grp = 0; grp < 6; ++grp) { const int kap0 = 8 * grp;
        float E[8], tot[8]; gate_scan<MX>(P, h, d, kap0, z, lane, E, tot);
        float kk[8]; unpack8(R.k[grp], kk);
        if (MX == 0) rope8r(rp[grp][0], rp[grp][1], kk);
        float ex[8];
#pragma unroll
        for (int e = 0; e < 8; ++e) ex[e] = __expf(E[e]);
        if constexpr (MX == 1) { u32x4 w; w.x = pk2(ex[0], ex[1]); w.y = pk2(ex[2], ex[3]); w.z = pk2(ex[4], ex[5]); w.w = pk2(ex[6], ex[7]);
            *(u32x4*)(EX + ex_off(rowt, d * 192 + h * 48 + kap0)) = w; }
        LAS bf16_t* o = KHT + ((h * 2 + d) * 48 + kap0) * 72 + lane;
#pragma unroll
        for (int e = 0; e < 8; ++e) o[e * 72] = f2bf(kk[e] * ex[e]);
        if (lane == 0) { float* dp = P.DEC + ((((size_t)(MX * 32 + b) * 36 + c) * 4 + h) * 2 + d) * 48 + kap0;
#pragma unroll
            for (int e = 0; e < 8; ++e) dp[e] = __expf(tot[e]); } }
}
__device__ __forceinline__ void mix_state_phase(const MixP& P, bf16_t* EX, LAS unsigned char* lds, int blk, int G) {
    int tid = threadIdx.x; asm volatile("" : "+v"(tid));
    const int wid = __builtin_amdgcn_readfirstlane(tid >> 6), lane = tid & 63;
    LAS bf16_t* vT = (LAS bf16_t*)lds;
    LAS bf16_t* KHT = (LAS bf16_t*)(lds + 4 * 96 * 72 * 2);
    int it = blk; StRegs R;
    int mx = it / 1152, bc = it - mx * 1152, b = bc / 36, c = bc - 36 * b;
    if (it < 2304) state_load(P, mx, b, c, R, wid, lane);
    while (it < 2304) {
        if (mx == 0) state_write<0>(P, b, c, R, vT, KHT, EX, wid, lane); else state_write<1>(P, b, c, R, vT, KHT, EX, wid, lane);
        __syncthreads();
        const int cmx = mx, cb = b, cc = c;
        const int nit = it + G;
        if (nit < 2304) { mx = nit / 1152; bc = nit - mx * 1152; b = bc / 36; c = bc - 36 * b; state_load(P, mx, b, c, R, wid, lane); }
        { const int h = wid >> 1, d = wid & 1, fr = lane & 15, fq = lane >> 4;
          f32x4 acc[6][3];
#pragma unroll
          for (int i = 0; i < 6; ++i)
#pragma unroll
              for (int j = 0; j < 3; ++j) acc[i][j] = (f32x4){0.f, 0.f, 0.f, 0.f};
#pragma unroll
          for (int ks = 0; ks < 2; ++ks) { bf16x8 bq[3];
#pragma unroll
              for (int j = 0; j < 3; ++j) bq[j] = ldsfrag(KHT + ((h * 2 + d) * 48 + 16 * j + fr) * 72 + 32 * ks + 8 * fq);
#pragma unroll
              for (int i = 0; i < 6; ++i) { const bf16x8 a = ldsfrag(vT + (h * 96 + 16 * i + fr) * 72 + 32 * ks + 8 * fq);
#pragma unroll
                  for (int j = 0; j < 3; ++j) acc[i][j] = __builtin_amdgcn_mfma_f32_16x16x32_bf16(bq[j], a, acc[i][j], 0, 0, 0); } }
          bf16_t* sp = P.ST + (((((size_t)(cmx * 32 + cb) * 4 + h) * 2 + d) * 36 + cc) * 4608);
#pragma unroll
          for (int i = 0; i < 6; ++i)
#pragma unroll
              for (int j = 0; j < 3; ++j) { u32x2 w; w.x = pk2(acc[i][j][0], acc[i][j][1]); w.y = pk2(acc[i][j][2], acc[i][j][3]);
                  *(u32x2*)(sp + (16 * i + fr) * 48 + 16 * j + 4 * fq) = w; } }
        __syncthreads();
        it = nit;
    }
}
__device__ __forceinline__ int chunk_order36(int d, int ci) { return d == 0 ? ci : (ci < 4 ? 3 - ci : 39 - ci); }
__device__ __forceinline__ int chunk_order72(int d, int ci) { return d == 0 ? ci : (ci < 8 ? 7 - ci : 79 - ci); }
__device__ __forceinline__ void mix_scan_phase(const MixP& P, int blk, int G) {
    const int tid = fresh_tid();
    for (int w = blk * 4 + (tid >> 7); w < 512 * 9; w += 4 * G) {
        const int seq = w / 9, e = ((w - seq * 9) * 128 + (tid & 127)) * 4, kap = e % 48;
        const int d = seq & 1, h = (seq >> 1) & 3, mb = seq >> 3;
        bf16_t* base = P.ST + (size_t)seq * 36 * 4608 + e;
        const float* dbase = P.DEC + (size_t)mb * 36 * 384 + (h * 2 + d) * 48 + kap;
        f32x4 S = {0.f, 0.f, 0.f, 0.f};
#pragma unroll
        for (int half = 0; half < 2; ++half) {
            u32x2 dS[18]; f32x4 dc[18];
#pragma unroll
            for (int j = 0; j < 18; ++j) { const int c = chunk_order36(d, half * 18 + j); dS[j] = *(const u32x2*)(base + (size_t)c * 4608); dc[j] = *(const f32x4*)(dbase + c * 384); }
#pragma unroll
            for (int j = 0; j < 18; ++j) { const f32x4 p = dc[j] * S; S[0] = p[0] + bflo(dS[j].x); S[1] = p[1] + bfhi(dS[j].x); S[2] = p[2] + bflo(dS[j].y); S[3] = p[3] + bfhi(dS[j].y);
                dS[j].x = pk2(p[0], p[1]); dS[j].y = pk2(p[2], p[3]); }
#pragma unroll
            for (int j = 0; j < 18; ++j) { const int c = chunk_order36(d, half * 18 + j); *(u32x2*)(base + (size_t)c * 4608) = dS[j]; }
        }
    }
}
struct OutRegs { u32x4 v[3]; u32x4 k[3], q[3], ex[3]; };
__device__ __forceinline__ void out_load(const MixP& P, const bf16_t* EX, const ItemId& I, OutRegs& R, int tid, int wid, int lane) {
    const int voff = I.mx ? 1536 : 384, qoff = I.mx ? 1152 : 0, koff = I.mx ? 1344 : 192;
    const size_t rowt = I.row0 + lane;
#pragma unroll
    for (int pass = 0; pass < 3; ++pass) { const int grp = pass * 8 + wid, h2 = grp / 12, dv0 = (grp - 12 * h2) * 8; R.v[pass] = *(const u32x4*)(P.PM + pm_off(rowt, voff + (2 * I.hp + h2) * 96 + dv0)); }
    const int h2 = wid >> 2, d = (wid >> 1) & 1, kh = wid & 1, h = 2 * I.hp + h2;
#pragma unroll
    for (int grp = 0; grp < 3; ++grp) { const int kap0 = 24 * kh + 8 * grp;
        R.k[grp] = *(const u32x4*)(P.PM + pm_off(rowt, koff + h * 48 + kap0)); R.q[grp] = *(const u32x4*)(P.PM + pm_off(rowt, qoff + h * 48 + kap0));
        if (I.mx == 1) R.ex[grp] = *(const u32x4*)(EX + ex_off(rowt, d * 192 + h * 48 + kap0)); else R.ex[grp] = (u32x4){0u, 0u, 0u, 0u}; }
}
template <int MX> __device__ __forceinline__ void out_write(const MixP& P, const ItemId& I, const OutRegs& R, LAS bf16_t* vT, LAS bf16_t* QC, LAS bf16_t* KH, LAS bf16_t* SpT, int tid, int wid, int lane) {
    const int h2 = wid >> 2, d = (wid >> 1) & 1, kh = wid & 1, h = 2 * I.hp + h2;
    u32x4 sp[5]; f32x4 rp[3][2];
#pragma unroll
    for (int i = 0; i < 5; ++i) { const int idx = tid + 512 * i;
        if (idx < 2304) { const int q4 = idx / 576, off = idx - q4 * 576;
            sp[i] = *(const u32x4*)(P.ST + (((((size_t)(I.mx * 32 + I.b) * 4 + (2 * I.hp + (q4 >> 1))) * 2 + (q4 & 1)) * 36 + I.c) * 4608) + off * 8); }
        else sp[i] = (u32x4){0u, 0u, 0u, 0u}; }
#pragma unroll
    for (int grp = 0; grp < 3; ++grp) { const int kap0 = 24 * kh + 8 * grp;
        if (MX == 0 && I.c >= 4) { const float* t = P.rope + ((size_t)((I.c - 4) * 64 + lane) * 24 + (kap0 >> 1)) * 2; rp[grp][0] = *(const f32x4*)t; rp[grp][1] = *(const f32x4*)(t + 4); }
        else { rp[grp][0] = (f32x4){1.f, 0.f, 1.f, 0.f}; rp[grp][1] = (f32x4){1.f, 0.f, 1.f, 0.f}; } }
    vT_write(R.v, vT, wid, lane);
    float rex = 1.f, rexi = 1.f;
    if constexpr (MX == 0) { const float Ev = P.ret_ld[d * 4 + h] * (float)(d == 0 ? 63 - lane : lane); rex = __expf(Ev); rexi = __expf(-Ev); }
#pragma unroll
    for (int grp = 0; grp < 3; ++grp) { const int kap0 = 24 * kh + 8 * grp;
        float kk[8], qq[8]; unpack8(R.k[grp], kk); unpack8(R.q[grp], qq);
        rope8r(rp[grp][0], rp[grp][1], kk); rope8r(rp[grp][0], rp[grp][1], qq);
        if constexpr (MX == 0) {
#pragma unroll
            for (int e = 0; e < 8; ++e) { kk[e] *= rex; qq[e] *= rexi; }
        } else { float ex[8]; unpack8(R.ex[grp], ex);
#pragma unroll
            for (int e = 0; e < 8; ++e) { kk[e] *= ex[e]; qq[e] *= __builtin_amdgcn_rcpf(ex[e]); } }
        u32x4 wk, wq; wk.x = pk2(kk[0], kk[1]); wk.y = pk2(kk[2], kk[3]); wk.z = pk2(kk[4], kk[5]); wk.w = pk2(kk[6], kk[7]);
        wq.x = pk2(qq[0], qq[1]); wq.y = pk2(qq[2], qq[3]); wq.z = pk2(qq[4], qq[5]); wq.w = pk2(qq[6], qq[7]);
        *(LAS u32x4*)(KH + ((h2 * 2 + d) * 64 + lane) * 48 + kap0) = wk;
        *(LAS u32x4*)(QC + ((h2 * 2 + d) * 64 + lane) * 48 + kap0) = wq; }
#pragma unroll
    for (int i = 0; i < 5; ++i) { const int idx = tid + 512 * i; if (idx < 2304) *(LAS u32x4*)(SpT + idx * 8) = sp[i]; }
}
__device__ __forceinline__ void mix_out_phase(const MixP& P, const bf16_t* EX, LAS unsigned char* lds, int blk, int G, int skip) {
    int tid = threadIdx.x; asm volatile("" : "+v"(tid));
    const int wid = __builtin_amdgcn_readfirstlane(tid >> 6), lane = tid & 63;
    LAS bf16_t* vT = (LAS bf16_t*)lds;
    LAS bf16_t* QC = (LAS bf16_t*)(lds + 27648);
    LAS bf16_t* KH = (LAS bf16_t*)(lds + 27648 + 24576);
    LAS bf16_t* SpT = (LAS bf16_t*)(lds + 27648 + 2 * 24576);
    LAS bf16_t* ATT = (LAS bf16_t*)(lds + 27648 + 2 * 24576 + 36864);
    LAS float* GAINS = (LAS float*)(lds + 27648 + 2 * 24576 + 36864 + 18432);
    for (int idx = tid; idx < 768; idx += 512) GAINS[idx] = idx < 384 ? P.ret_gn[idx] : P.gnorm[idx - 384];
    int it = next_item(blk, G, skip); OutRegs R; ItemId I = item_decode(it < 4608 ? it : 0);
    if (it < 4608) out_load(P, EX, I, R, tid, wid, lane);
    while (it < 4608) {
        if (I.mx == 0) out_write<0>(P, I, R, vT, QC, KH, SpT, tid, wid, lane); else out_write<1>(P, I, R, vT, QC, KH, SpT, tid, wid, lane);
        __syncthreads();
        const int mx = I.mx, hp = I.hp; const size_t row0 = I.row0;
        const int nit = next_item(it + G, G, skip);
        if (nit < 4608) { I = item_decode(nit); out_load(P, EX, I, R, tid, wid, lane); }
        if (wid < 4) {
            const int h2 = wid >> 1, ih = wid & 1, i0 = 32 * ih, h = 2 * hp + h2, l31 = lane & 31, lh = lane >> 5;
            LAS bf16_t* att = ATT + wid * 32 * 72;
#pragma unroll
            for (int jt = 0; jt < 2; ++jt) {
                f32x16 af, ab;
#pragma unroll
                for (int e = 0; e < 16; ++e) { af[e] = 0.f; ab[e] = 0.f; }
#pragma unroll
                for (int ks = 0; ks < 3; ++ks) {
                    const bf16x8 a0 = ldsfrag(KH + ((h2 * 2 + 0) * 64 + 32 * jt + l31) * 48 + 16 * ks + 8 * lh), q0 = ldsfrag(QC + ((h2 * 2 + 0) * 64 + i0 + l31) * 48 + 16 * ks + 8 * lh);
                    const bf16x8 a1 = ldsfrag(KH + ((h2 * 2 + 1) * 64 + 32 * jt + l31) * 48 + 16 * ks + 8 * lh), q1 = ldsfrag(QC + ((h2 * 2 + 1) * 64 + i0 + l31) * 48 + 16 * ks + 8 * lh);
                    af = __builtin_amdgcn_mfma_f32_32x32x16_bf16(a0, q0, af, 0, 0, 0);
                    ab = __builtin_amdgcn_mfma_f32_32x32x16_bf16(a1, q1, ab, 0, 0, 0); }
                const int ig = i0 + l31;
#pragma unroll
                for (int q = 0; q < 4; ++q) { float v[4];
#pragma unroll
                    for (int e = 0; e < 4; ++e) { const int jg = 32 * jt + 8 * q + 4 * lh + e; v[e] = (jg <= ig ? af[4 * q + e] : 0.f) + (jg >= ig ? ab[4 * q + e] : 0.f); }
                    u32x2 w; w.x = pk2(v[0], v[1]); w.y = pk2(v[2], v[3]);
                    *(LAS u32x2*)(att + l31 * 72 + 32 * jt + 8 * q + 4 * lh) = w; }
            }
            LDS_WAIT();
            f32x16 o[3];
#pragma unroll
            for (int mt = 0; mt < 3; ++mt) {
#pragma unroll
                for (int e = 0; e < 16; ++e) o[mt][e] = 0.f;
#pragma unroll
                for (int ks = 0; ks < 4; ++ks) o[mt] = __builtin_amdgcn_mfma_f32_32x32x16_bf16(ldsfrag(vT + (h2 * 96 + 32 * mt + l31) * 72 + 16 * ks + 8 * lh), ldsfrag(att + l31 * 72 + 16 * ks + 8 * lh), o[mt], 0, 0, 0);
#pragma unroll
                for (int d = 0; d < 2; ++d)
#pragma unroll
                    for (int ks = 0; ks < 3; ++ks) o[mt] = __builtin_amdgcn_mfma_f32_32x32x16_bf16(ldsfrag(SpT + ((h2 * 2 + d) * 96 + 32 * mt + l31) * 48 + 16 * ks + 8 * lh), ldsfrag(QC + ((h2 * 2 + d) * 64 + i0 + l31) * 48 + 16 * ks + 8 * lh), o[mt], 0, 0, 0);
            }
            float s = 0.f;
#pragma unroll
            for (int mt = 0; mt < 3; ++mt)
#pragma unroll
                for (int e = 0; e < 16; ++e) s += o[mt][e];
            s += __shfl_xor(s, 32);
            const float mu = (mx == 0) ? s * (1.0f / 96.0f) : 0.f;
            float s2 = 0.f;
#pragma unroll
            for (int mt = 0; mt < 3; ++mt)
#pragma unroll
                for (int e = 0; e < 16; ++e) { const float dlt = o[mt][e] - mu; s2 += dlt * dlt; }
            s2 += __shfl_xor(s2, 32);
            const float rstd = rsqrtf(s2 * (1.0f / 96.0f) + EPS);
            const LAS float* gain = GAINS + mx * 384 + h * 96;
            const size_t rowt = row0 + i0 + l31;
            const bf16_t* gp = P.PM + pm_off(rowt, (mx ? 1920 : 768) + h * 96) + 4 * lh;
            bf16_t* yp = P.Y + rowt * 1024 + 256 + mx * 384 + h * 96;
            u32x2 gring[2]; gring[0] = *(const u32x2*)(gp);
#pragma unroll
            for (int mt = 0; mt < 3; ++mt)
#pragma unroll
                for (int q = 0; q < 4; ++q) { const int dv = 32 * mt + 8 * q + 4 * lh, t = 4 * mt + q;
                    if (t + 1 < 12) gring[(t + 1) & 1] = *(const u32x2*)(gp + 512 * (t + 1));
                    const u32x2 gv = gring[t & 1]; const f32x4 g4 = *(const LAS f32x4*)(gain + dv);
                    const float y0 = (o[mt][4 * q + 0] - mu) * rstd * g4[0] * siluf_(bflo(gv.x)), y1 = (o[mt][4 * q + 1] - mu) * rstd * g4[1] * siluf_(bfhi(gv.x));
                    const float y2 = (o[mt][4 * q + 2] - mu) * rstd * g4[2] * siluf_(bflo(gv.y)), y3 = (o[mt][4 * q + 3] - mu) * rstd * g4[3] * siluf_(bfhi(gv.y));
                    u32x2 w; w.x = pk2(y0, y1); w.y = pk2(y2, y3);
                    *(u32x2*)(yp + dv) = w; }
        }
        __syncthreads();
        it = nit;
    }
}

__device__ __forceinline__ void s5_scan_phase(const float* AP, const float* SS, bf16_t* UH, int blk, int G) {
    const int tid = fresh_tid();
    if (tid < 256) {
        for (int idx = blk * 256 + tid; idx < 65536; idx += G * 256) {
            const int p = idx & 63, d = (idx >> 6) & 1, g = (idx >> 7) & 15, b = idx >> 11;
            const float* ap = AP + ((((size_t)g * 2 + d) * 64 + p) * 33 + 32) * 2;
            const float ar = ap[0], ai = ap[1];
            float hr = 0.f, hi = 0.f;
            for (int c0 = 0; c0 < 72; c0 += 24) {
                float sr[24], si[24];
#pragma unroll
                for (int j = 0; j < 24; ++j) { const int c = chunk_order72(d, c0 + j); const float* sp = SS + ((size_t)g * 2304 + b * 72 + c) * 256 + d * 128 + p; sr[j] = sp[0]; si[j] = sp[64]; }
#pragma unroll
                for (int j = 0; j < 24; ++j) { const int c = chunk_order72(d, c0 + j); bf16_t* hp = UH + ((size_t)g * 2304 + b * 72 + c) * 768 + 512 + d * 128 + p;
                    hp[0] = f2bf(hr); hp[64] = f2bf(hi);
                    const float nr = ar * hr - ai * hi + sr[j], ni = ar * hi + ai * hr + si[j]; hr = nr; hi = ni; }
            }
        }
    }
}

#ifndef DBG_STOP
#define DBG_STOP 0
#endif
__device__ __forceinline__ void dbg_digest_bf16(float* out, const bf16_t* buf, size_t n, int ld, int c0, int c1, int blk, int G, bool first) {
    const size_t NOUT = (size_t)NB * SEQ * D;
    for (size_t i = (size_t)blk * 512 + fresh_tid(); i < NOUT; i += (size_t)G * 512) { float s = first ? 0.f : out[i];
        for (size_t j = i; j < n; j += NOUT) { const int c = (int)(j % ld); if (c >= c0 && c < c1) s += bf2f(buf[j]); }
        out[i] = s; }
}
__device__ __forceinline__ void dbg_digest_f32(float* out, const float* buf, size_t n, int blk, int G, bool first) {
    const size_t NOUT = (size_t)NB * SEQ * D;
    for (size_t i = (size_t)blk * 512 + fresh_tid(); i < NOUT; i += (size_t)G * 512) { float s = first ? 0.f : out[i];
        for (size_t j = i; j < n; j += NOUT) s += buf[j];
        out[i] = s; }
}

#define KAS __attribute__((address_space(4)))
__device__ __forceinline__ const KAS unsigned char* karg_() { const KAS unsigned char* ka = (const KAS unsigned char*)__builtin_amdgcn_kernarg_segment_ptr(); asm volatile("" : "+s"(ka)); return ka; }
__device__ __forceinline__ const float* IN_(int k) { return *(const float* const KAS*)(karg_() + 8 * k); }
__device__ __forceinline__ float* OUT_() { return *(float* const KAS*)(karg_() + 248); }
__device__ __forceinline__ unsigned char* WS_() { return *(unsigned char* const KAS*)(karg_() + 256); }
__global__ void __launch_bounds__(512, 2) fwd_megakernel(Params prm) {
    extern __shared__ __attribute__((aligned(16))) unsigned char smem[];
    LAS unsigned char* lds = (LAS unsigned char*)smem;
    cg::grid_group grid = cg::this_grid();
    const int G = gridDim.x, blk = blockIdx.x, NGW = G * 8;
#define ws WS_()
    volatile LAS unsigned* bst = (volatile LAS unsigned*)(lds + LDS_BYTES - 16);
    if (threadIdx.x == 0) { bst[0] = 0u; bst[1] = 0u; }
    __syncthreads();
    (void)xcd_barrier_post((unsigned*)(ws + WS_BAR), bst);
#define XBAR() do { XcdBarrier _xb; _xb.bar = (unsigned*)(WS_() + WS_BAR); _xb.x = xb_xcc_id(); _xb.st = (volatile LAS unsigned*)(lds + LDS_BYTES - 16); xcd_barrier(_xb); } while (0)
#define Wb ((bf16_t*)(WS_() + WS_W))
#define Tb ((float*)(WS_() + WS_T))
#define MOD ((float*)(WS_() + WS_MOD))
#define ROPE ((float*)(WS_() + WS_ROPE))
#define CTXR ((float*)(WS_() + WS_CTX))
#define XN ((bf16_t*)(WS_() + WS_XN))
#define ST ((bf16_t*)(WS_() + WS_ST))
#define DEC ((float*)(WS_() + WS_DEC))
#define PM ((bf16_t*)(WS_() + WS_PM))
#define UH ((bf16_t*)(WS_() + WS_UH))
#define YB ((bf16_t*)(WS_() + WS_YB))
#define Hb ((bf16_t*)(WS_() + WS_H))
#define Y ((bf16_t*)(WS_() + WS_Y))
#define M1 ((bf16_t*)(WS_() + WS_M1))
#define Y5 ((bf16_t*)(WS_() + WS_Y5))
#define SS ((float*)(WS_() + WS_SS))
#define OUT OUT_()

    {
        const int tid = fresh_tid(), wid = __builtin_amdgcn_readfirstlane(tid >> 6), lane = tid & 63, gw = blk * 8 + wid;
        for (int idx = blk * 512 + tid; idx < 2048 * 24; idx += G * 512) { const int t = idx / 24, i = idx - 24 * t; const int pos = i < 12 ? (t >> 6) : (t & 63);
            const float inv = exp2f(-(float)(i % 12) * (13.287712379549449f / 12.0f)); const float ang = (float)pos * inv;
            ROPE[2 * idx] = cosf(ang); ROPE[2 * idx + 1] = sinf(ang); }
        if (G <= 192 || blk >= 192) {
            const int nb5 = (G > 192 ? (G - 192) : G) * 512, i05 = (G > 192 ? (blk - 192) : blk) * 512 + tid;
            for (int idx = i05; idx < 4096 * 33; idx += nb5) {
                const int q = idx / 33, tau = idx - 33 * q; const int p = q & 63, d = (q >> 6) & 1, g = (q >> 7) & 15, l = q >> 11;
                const float lr = IN_(9)[((size_t)(l * 2 + d) * 16 + g) * 64 + p], li = IN_(10)[((size_t)(l * 2 + d) * 16 + g) * 64 + p];
                const float dtp = expf(IN_(11)[(l * 2 + d) * 16 + g]);
                float* ap = Tb + (size_t)l * TL_END + TL_AP + (((size_t)g * 2 + d) * 64 + p) * 33 * 2;
                const float mag = expf(lr * dtp * (float)tau);
                double ang = (double)li * (double)dtp * (double)tau; ang -= 6.283185307179586 * rint(ang * 0.15915494309189535);
                const float af = (float)ang; ap[2 * tau] = mag * cosf(af); ap[2 * tau + 1] = mag * sinf(af); }
            for (int idx = i05; idx < 4096; idx += nb5) {
                const int p = idx & 63, d = (idx >> 6) & 1, g = (idx >> 7) & 15, l = idx >> 11;
                const float lr = IN_(9)[((size_t)(l * 2 + d) * 16 + g) * 64 + p], li = IN_(10)[((size_t)(l * 2 + d) * 16 + g) * 64 + p];
                const float dtp = expf(IN_(11)[(l * 2 + d) * 16 + g]);
                const float th = li * dtp, em1 = expm1f(lr * dtp), sh = sinf(0.5f * th);
                const float am1r = em1 * cosf(th) - 2.0f * sh * sh, aim = (em1 + 1.0f) * sinf(th);
                const float den = lr * lr + li * li;
                const float fr_ = (am1r * lr + aim * li) / den, fi_ = (aim * lr - am1r * li) / den;
                float* bbp = Tb + (size_t)l * TL_END + TL_BB + (((size_t)g * 2 + d) * 64 + p) * 16 * 2;
                const float* br = IN_(12) + (((size_t)l * 16 + g) * 64 + p) * 16; const float* bi = IN_(13) + (((size_t)l * 16 + g) * 64 + p) * 16;
                for (int c = 0; c < 16; ++c) { bbp[2 * c] = fr_ * br[c] - fi_ * bi[c]; bbp[2 * c + 1] = fr_ * bi[c] + fi_ * br[c]; } }
        }
        __syncthreads();
        if (blk < 192) {
            constexpr int SCS = 1028;
            LAS float* sc = (LAS float*)lds;
            for (int idx = tid; idx < 33 * 256; idx += 512) { const int mv = idx >> 8, k = (idx & 255) * 4; const f32x4 v = mv < 32 ? *(const f32x4*)(IN_(1) + mv * 1024 + k) : *(const f32x4*)(IN_(3) + k);
                *(LAS f32x4*)(sc + mv * SCS + k) = (f32x4){siluf_(v[0]), siluf_(v[1]), siluf_(v[2]), siluf_(v[3])}; }
            __syncthreads();
            const int l = blk / 96, n0 = (blk % 96) * 64, l31 = lane & 31, lh = lane >> 5;
            const float* wm = IN_(4) + (size_t)l * 1024 * 6144 + n0;
            f32x16 acc0, acc1; float accx = 0.f;
#pragma unroll
            for (int e = 0; e < 16; ++e) { acc0[e] = 0.f; acc1[e] = 0.f; }
#pragma unroll 8
            for (int k = wid * 128; k < wid * 128 + 128; k += 2) {
                const float a = sc[l31 * SCS + k + lh];
                const float b0 = wm[(size_t)(k + lh) * 6144 + l31], b1 = wm[(size_t)(k + lh) * 6144 + 32 + l31];
                acc0 = __builtin_amdgcn_mfma_f32_32x32x2f32(a, b0, acc0, 0, 0, 0);
                acc1 = __builtin_amdgcn_mfma_f32_32x32x2f32(a, b1, acc1, 0, 0, 0);
                accx += sc[32 * SCS + k] * wm[(size_t)k * 6144 + lane] + sc[32 * SCS + k + 1] * wm[(size_t)(k + 1) * 6144 + lane]; }
            __syncthreads();
            LAS float* red = (LAS float*)lds;
#pragma unroll
            for (int r = 0; r < 16; ++r) { const int mv = (r & 3) + 8 * (r >> 2) + 4 * lh;
                red[(wid * 33 + mv) * 64 + l31] = acc0[r]; red[(wid * 33 + mv) * 64 + 32 + l31] = acc1[r]; }
            red[(wid * 33 + 32) * 64 + lane] = accx;
            __syncthreads();
            for (int idx = tid; idx < 33 * 64; idx += 512) { const int mv = idx >> 6, ln = idx & 63; float s = 0.f;
#pragma unroll
                for (int w = 0; w < 8; ++w) s += red[(w * 33 + mv) * 64 + ln];
                const int nn = (blk % 96) * 64 + ln; MOD[((size_t)l * 33 + mv) * 6144 + nn] = s + IN_(5)[l * 6144 + nn]; }
        }
    }
    GSYNC();
    {
        const int tid = fresh_tid(), wid = __builtin_amdgcn_readfirstlane(tid >> 6), lane = tid & 63, gw = blk * 8 + wid;
        LAS float* scr = (LAS float*)(lds + wid * 8448);
        const float qs = 0.14433756729740643f;
        for (int l = 0; l < 2; ++l) {
            bf16_t* W = Wb + (size_t)l * WL_END;
            const float* w_in = IN_(8) + (size_t)l * 1024 * INDIM;
            xpose_job(w_in, INDIM, 1024, 448, 0, W + WL_MIX, 1024, 0, 1.0f, 0, gw, NGW, scr, lane);
            xpose_job(w_in, INDIM, 1024, 192, 448, W + WL_MIX, 1024, 448, qs, 0, gw, NGW, scr, lane);
            xpose_job(w_in, INDIM, 1024, 768, 640, W + WL_MIX, 1024, 640, 1.0f, 0, gw, NGW, scr, lane);
            xpose_job(w_in, INDIM, 1024, 192, 1408, W + WL_MIX, 1024, 1408, qs, 0, gw, NGW, scr, lane);
            xpose_job(w_in, INDIM, 1024, 992, 1600, W + WL_MIX, 1024, 1600, 1.0f, 0, gw, NGW, scr, lane);
            xpose_job(w_in, INDIM, 1024, 3072, 2592, W + WL_G, 1024, 0, 1.0f, 0, gw, NGW, scr, lane);
            xpose_job(IN_(24) + (size_t)l * 256 * 1024, 1024, 256, 1024, 0, W + WL_BR, 1024, 0, 1.0f, 0, gw, NGW, scr, lane);
            xpose_job(IN_(25) + (size_t)l * 384 * 1024, 1024, 384, 1024, 0, W + WL_BR + 256, 1024, 0, 1.0f, 0, gw, NGW, scr, lane);
            xpose_job(IN_(26) + (size_t)l * 384 * 1024, 1024, 384, 1024, 0, W + WL_BR + 640, 1024, 0, 1.0f, 0, gw, NGW, scr, lane);
            xpose_job(IN_(27) + (size_t)l * 1024 * 1024, 1024, 1024, 1024, 0, W + WL_OUT, 1024, 0, 1.0f, 0, gw, NGW, scr, lane);
            xpose_job(IN_(28) + (size_t)l * 1024 * NFFI, NFFI, 1024, NFFI, 0, W + WL_FFI, 1024, 0, 1.0f, 1, gw, NGW, scr, lane);
            xpose_job(IN_(29) + (size_t)l * FFH * 1024, 1024, FFH, 1024, 0, W + WL_FFO, FFH, 0, 1.0f, 0, gw, NGW, scr, lane);
            xpose_job(IN_(17) + (size_t)l * 256 * 256, 256, 256, 256, 0, W + WL_GLU, 256, 0, 1.0f, 0, gw, NGW, scr, lane);
            for (size_t i = (size_t)blk * 512 + tid; i < (size_t)224 * 1024 / 8; i += (size_t)G * 512) *(u32x4*)(W + WL_MIX + (size_t)2592 * 1024 + i * 8) = (u32x4){0u, 0u, 0u, 0u};
        }
    }
    for (int idx = blk * 512 + fresh_tid(); idx < 2 * 16 * 2 * 32 * 16 * 4; idx += G * 512) {
        const int cq = idx & 3, c = (idx >> 2) & 15, tau = (idx >> 6) & 31, d = (idx >> 11) & 1, g = (idx >> 12) & 15, l = idx >> 16;
        const float* Tq = Tb + (size_t)l * TL_END;
        const float* cr = IN_(14) + (((size_t)l * 16 + g) * 16 + c) * 64; const float* ci = IN_(15) + (((size_t)l * 16 + g) * 16 + c) * 64;
        const float* apb = Tq + TL_AP + ((size_t)g * 2 + d) * 64 * 33 * 2 + tau * 2; const float* bpb = Tq + TL_BB + ((size_t)g * 2 + d) * 64 * 16 * 2 + cq * 8;
        f32x4 s4 = {0.f, 0.f, 0.f, 0.f};
#pragma unroll 4
        for (int p = 0; p < 64; ++p) { const f32v2_t a2 = *(const f32v2_t*)(apb + p * 66); const f32x4 b0 = *(const f32x4*)(bpb + p * 32), b1 = *(const f32x4*)(bpb + p * 32 + 4);
            const float wr_ = cr[p] * a2[0] - ci[p] * a2[1], wi_ = cr[p] * a2[1] + ci[p] * a2[0];
            s4[0] += wr_ * b0[0] - wi_ * b0[1]; s4[1] += wr_ * b0[2] - wi_ * b0[3]; s4[2] += wr_ * b1[0] - wi_ * b1[1]; s4[3] += wr_ * b1[2] - wi_ * b1[3]; }
        *(f32x4*)((float*)Tq + TL_KT + ((((size_t)g * 2 + d) * 32 + tau) * 16 + c) * 16 + cq * 4) = s4;
    }
    norm_mod_phase(IN_(0), IN_(2), IN_(6), MOD, 0, XN, blk, NGW, 0);
    XBAR();

    for (int l = 0; l < 2; ++l) {
        const int skip = (l == 1) ? 1 : 0, nMe = skip ? 256 : NRT;
#define W (Wb + (size_t)l * WL_END)
#define T (Tb + (size_t)l * TL_END)
#define MODl (MOD + (size_t)l * 33 * 6144)
#define slat (l == 0 ? IN_(0) : (const float*)OUT)
#define sctx (l == 0 ? IN_(2) : (const float*)CTXR)
        const MixP MP{PM, (l == 0) ? (bf16_t*)OUT : ST, DEC, Y, ROPE, IN_(19) + l * 8, IN_(20) + l * 384, IN_(21) + (size_t)l * 2 * 16 * 192, IN_(22) + l * 2 * 192, IN_(23) + l * 384};
        if (l != 0) { norm_mod_mid_phase((const bf16_t*)OUT, IN_(6) + l * 1024, MODl, 0, XN, blk, NGW, 0);
            XBAR(); }
        if (l == 0) { SchedPlain S{(const char*)XN, (const char*)(W + WL_MIX), (size_t)256 * 1024 * 2, (size_t)256 * 1024 * 2, NRT, NMIX / 256, 16, G, blk, 0};
          EpiInProj E{PM, UH}; pg8::gemm_phase(lds, 1024, 1024, S, E); }
        else { SchedInProjLast S{(const char*)XN, (const char*)(W + WL_MIX), G, blk}; EpiInProj E{PM, UH}; pg8::gemm_phase(lds, 1024, 1024, S, E); }
        if (l == 0 && (G != 256 || blk >= 96)) {
            const int xb0 = (G == 256) ? blk - 96 : blk, xnb = (G == 256) ? 160 : G;
        for (size_t idx = (size_t)xb0 * 512 + fresh_tid(); idx < (size_t)2 * 16 * 512 * 96; idx += (size_t)xnb * 512) {
            const int k8 = (int)(idx % 96), n = (int)((idx / 96) & 511), g = (int)((idx / (96 * 512)) & 15), l = (int)(idx / (96 * 512 * 16));
            const float* Tq = Tb + (size_t)l * TL_END; const int t = n >> 4, c = n & 15, k0 = k8 * 8; float v[8];
            if (k0 < 512) { const int s = k0 >> 4, cp0 = k0 & 15;
#pragma unroll
                for (int e = 0; e < 8; ++e) { float x = 0.f;
                    if (s <= t) x += Tq[TL_KT + ((((size_t)g * 2 + 0) * 32 + (t - s)) * 16 + c) * 16 + cp0 + e];
                    if (s >= t) x += Tq[TL_KT + ((((size_t)g * 2 + 1) * 32 + (s - t)) * 16 + c) * 16 + cp0 + e];
                    if (s == t && c == cp0 + e) x += IN_(16)[l * 256 + g * 16 + c];
                    v[e] = x; }
            } else { const int kk = k0 - 512, d = kk >> 7, ri = (kk >> 6) & 1, p0 = kk & 63, tau = (d == 0 ? t : 31 - t) + 1;
#pragma unroll
                for (int e = 0; e < 8; ++e) { const int p = p0 + e; const float* ap = Tq + TL_AP + ((((size_t)g * 2 + d) * 64 + p) * 33 + tau) * 2;
                    const float cr = IN_(14)[(((size_t)l * 16 + g) * 16 + c) * 64 + p], ci = IN_(15)[(((size_t)l * 16 + g) * 16 + c) * 64 + p];
                    v[e] = ri == 0 ? (cr * ap[0] - ci * ap[1]) : -(cr * ap[1] + ci * ap[0]); } }
            u32x4 w; w.x = pk2(v[0], v[1]); w.y = pk2(v[2], v[3]); w.z = pk2(v[4], v[5]); w.w = pk2(v[6], v[7]);
            *(u32x4*)(Wb + (size_t)l * WL_END + WL_KCAT + (((size_t)g * 512 + n) * 768 + k0)) = w;
        }
        for (size_t idx = (size_t)xb0 * 512 + fresh_tid(); idx < (size_t)2 * 16 * 256 * 64; idx += (size_t)xnb * 512) {
            const int k8 = (int)(idx & 63), n = (int)((idx >> 6) & 255), g = (int)((idx >> 14) & 15), l = (int)(idx >> 18);
            const float* Tq = Tb + (size_t)l * TL_END; const int d = n >> 7, ri = (n >> 6) & 1, p = n & 63, k0 = k8 * 8, s = k0 >> 4, cp0 = k0 & 15, e_ = d == 0 ? 31 - s : s;
            const float* ap = Tq + TL_AP + ((((size_t)g * 2 + d) * 64 + p) * 33 + e_) * 2; float v[8];
#pragma unroll
            for (int e = 0; e < 8; ++e) { const float* bp = Tq + TL_BB + ((((size_t)g * 2 + d) * 64 + p) * 16 + cp0 + e) * 2;
                v[e] = ri == 0 ? (ap[0] * bp[0] - ap[1] * bp[1]) : (ap[0] * bp[1] + ap[1] * bp[0]); }
            u32x4 w; w.x = pk2(v[0], v[1]); w.y = pk2(v[2], v[3]); w.z = pk2(v[4], v[5]); w.w = pk2(v[6], v[7]);
            *(u32x4*)(Wb + (size_t)l * WL_END + WL_WST + (((size_t)g * 256 + n) * 512 + k0)) = w;
        }
        }
        XBAR();
#if DBG_STOP == 2
        if (l == 0) { dbg_digest_bf16(OUT, PM, (size_t)MROWS * PMLD, PMLD, 0, 2336, blk, G, true); dbg_digest_bf16(OUT, UH, (size_t)16 * 2304 * 768, 768, 0, 512, blk, G, false); return; }
#endif
        { SchedS5 S{(const char*)UH, (const char*)(W + WL_WST), 1, 512, 8, G, blk}; EpiS5State E{SS}; pg8::gemm_phase(lds, 768, 512, S, E); }
        __syncthreads();
        mix_state_phase(MP, (bf16_t*)(ws + WS_EX), lds, blk, G);
        XBAR();
#if DBG_STOP == 3
        if (l == 0) { dbg_digest_f32(OUT, DEC, (size_t)2 * 32 * 36 * 4 * 2 * 48, blk, G, true); return; }
#endif
        s5_scan_phase(T + TL_AP, SS, UH, blk, G);
        mix_scan_phase(MP, blk, G);
        XBAR();
#if DBG_STOP == 4
        if (l == 0) { dbg_digest_bf16(OUT, ST, ST_ELEMS, 48, 0, 48, blk, G, true); dbg_digest_bf16(OUT, UH, (size_t)16 * 2304 * 768, 768, 0, 768, blk, G, false); return; }
#endif
        { SchedS5 S{(const char*)UH, (const char*)(W + WL_KCAT), 2, 768, 12, G, blk}; EpiS5Out E{Y5}; pg8::gemm_phase(lds, 768, 768, S, E); }
        __syncthreads();
        mix_out_phase(MP, (const bf16_t*)(ws + WS_EX), lds, blk, G, skip);
        XBAR();
#if DBG_STOP == 5
        if (l == 0) { dbg_digest_bf16(OUT, Y, (size_t)MROWS * 1024, 1024, 256, 1024, blk, G, true); dbg_digest_bf16(OUT, Y5, (size_t)MROWS * 256, 256, 0, 256, blk, G, false); return; }
#endif
        { SchedPlain S{(const char*)Y5, (const char*)(W + WL_GLU), (size_t)256 * 256 * 2, (size_t)0, nMe, 1, 4, G, blk, skip};
          EpiGlu E{Y5, Y, IN_(18) + l * 256}; pg8::gemm_phase(lds, 256, 256, S, E); }
        if (l != 0) norm_mod_mid_phase((const bf16_t*)OUT, IN_(6) + l * 1024, MODl, 0, XN, blk, NGW, skip);
        XBAR();
#if DBG_STOP == 6
        if (l == 0) { dbg_digest_bf16(OUT, Y, (size_t)MROWS * 1024, 1024, 0, 1024, blk, G, true); dbg_digest_bf16(OUT, XN, (size_t)MROWS * 1024, 1024, 0, 1024, blk, G, false); return; }
#endif
        { SchedMerge S{(const char*)Y, (const char*)(W + WL_BR), (const char*)XN, (const char*)(W + WL_G), G, blk, nMe, skip};
          EpiMerge E{YB + (size_t)blk * 2 * 65536, M1}; pg8::gemm_phase(lds, 1024, 1024, S, E); }
        XBAR();
        { SchedPlain S{(const char*)M1, (const char*)(W + WL_OUT), (size_t)256 * 1024 * 2, (size_t)256 * 1024 * 2, nMe, 4, 16, G, blk, skip};
          if (l == 0) { EpiResidMid<false> E{IN_(0), IN_(2), (const bf16_t*)OUT, (bf16_t*)(WS_() + WS_R2), MODl + 2 * 1024}; pg8::gemm_phase(lds, 1024, 1024, S, E); }
          else { EpiResidMid<true> E{IN_(0), IN_(2), (const bf16_t*)OUT, (bf16_t*)(WS_() + WS_R2), MODl + 2 * 1024}; pg8::gemm_phase(lds, 1024, 1024, S, E); } }
        XBAR();
        norm_mod_mid_phase((const bf16_t*)(WS_() + WS_R2), IN_(7) + l * 1024, MODl, 3, XN, blk, NGW, skip);
        XBAR();
        { SchedPlain S{(const char*)XN, (const char*)(W + WL_FFI), (size_t)256 * 1024 * 2, (size_t)256 * 1024 * 2, nMe, NFFI / 256, 16, G, blk, skip};
          EpiSwiglu E{Hb}; pg8::gemm_phase(lds, 1024, 1024, S, E); }
        XBAR();
        { SchedPlain S{(const char*)Hb, (const char*)(W + WL_FFO), (size_t)256 * FFH * 2, (size_t)256 * FFH * 2, nMe, 4, FFH / 64, G, blk, skip};
          if (l == 0) { EpiResidOut<true> E{(const bf16_t*)(WS_() + WS_R2), OUT, (bf16_t*)OUT, MODl + 5 * 1024}; pg8::gemm_phase(lds, FFH, FFH, S, E); }
          else { EpiResidOut<false> E{(const bf16_t*)(WS_() + WS_R2), OUT, (bf16_t*)OUT, MODl + 5 * 1024}; pg8::gemm_phase(lds, FFH, FFH, S, E); } }
        XBAR();
    }
    final_norm_phase(OUT, IN_(30), blk, NGW);
}

#undef ws
#undef Wb
#undef Tb
#undef MOD
#undef ROPE
#undef CTXR
#undef XN
#undef ST
#undef DEC
#undef PM
#undef UH
#undef YB
#undef Hb
#undef Y
#undef M1
#undef Y5
#undef SS
#undef OUT
#undef W
#undef T
#undef MODl
#undef slat
#undef sctx
extern "C" void kernel_launch(void* const* d_in, const int* in_sizes, int n_in, void* d_out, int out_size, void* d_ws, size_t ws_size, hipStream_t stream) {
    static int grid_blocks = 0;
    if (!grid_blocks) {
        if (n_in != 31 || ws_size < WS_END) { fprintf(stderr, "kernel_launch: unexpected n_in %d or ws_size %zu (< %zu)\n", n_in, ws_size, (size_t)WS_END); grid_blocks = -1; return; }
        int dev = 0, cus = 0, per_cu = 0;
        hipGetDevice(&dev);
        hipDeviceGetAttribute(&cus, hipDeviceAttributeMultiprocessorCount, dev);
        hipFuncSetAttribute((const void*)fwd_megakernel, hipFuncAttributeMaxDynamicSharedMemorySize, LDS_BYTES);
        hipOccupancyMaxActiveBlocksPerMultiprocessor(&per_cu, (const void*)fwd_megakernel, 512, LDS_BYTES);
        if (per_cu < 1) { fprintf(stderr, "kernel_launch: occupancy query says %d blocks/CU\n", per_cu); per_cu = 1; }
        (void)hipGetLastError();
        grid_blocks = cus;
    }
    if (grid_blocks < 0) return;
    (void)hipMemsetAsync((unsigned char*)d_ws + WS_BAR, 0, BAR_BYTES, stream);
    Params p{};
    for (int i = 0; i < 31; ++i) p.in[i] = (const float*)d_in[i];
    p.out = (float*)d_out; p.ws = (unsigned char*)d_ws;
    void* args[] = {&p};
    hipError_t e = hipLaunchCooperativeKernel((const void*)fwd_megakernel, dim3(grid_blocks), dim3(512), args, LDS_BYTES, stream);
    if (e != hipSuccess) fprintf(stderr, "cooperative launch failed: %s (grid %d)\n", hipGetErrorString(e), grid_blocks);
}
```

```cpp
#include <hip/hip_runtime.h>
#include <hip/hip_cooperative_groups.h>
#include <cstdio>
namespace cg = cooperative_groups;

#define LAS __attribute__((address_space(3)))
typedef unsigned short bf16_t;
typedef short bf16x8 __attribute__((ext_vector_type(8)));
typedef float f32x4 __attribute__((ext_vector_type(4)));
typedef float f32x16 __attribute__((ext_vector_type(16)));
typedef unsigned u32x4 __attribute__((ext_vector_type(4)));
typedef unsigned u32x2 __attribute__((ext_vector_type(2)));

constexpr int D = 1024, NB = 32, SEQ = 2048, CTXL = 256, TOK = 2304, MROWS = NB * TOK;
constexpr int NRT = MROWS / 256;
constexpr int NMIX = 2816, NGATE = 3072, FFH = 2816, NFFI = 5632, INDIM = 5664, PMLD = 2560;
constexpr float EPS = 1e-6f;
constexpr int LDS_BYTES = 160 * 1024;

constexpr size_t al256(size_t x) { return (x + 255) & ~(size_t)255; }
constexpr size_t WL_MIX = 0;
constexpr size_t WL_G = WL_MIX + (size_t)NMIX * 1024;
constexpr size_t WL_BR = WL_G + (size_t)NGATE * 1024;
constexpr size_t WL_OUT = WL_BR + (size_t)1024 * 1024;
constexpr size_t WL_FFI = WL_OUT + (size_t)1024 * 1024;
constexpr size_t WL_FFO = WL_FFI + (size_t)NFFI * 1024;
constexpr size_t WL_GLU = WL_FFO + (size_t)1024 * FFH;
constexpr size_t WL_KCAT = WL_GLU + (size_t)256 * 256;
constexpr size_t WL_WST = WL_KCAT + (size_t)16 * 512 * 768;
constexpr size_t WL_END = WL_WST + (size_t)16 * 256 * 512;
constexpr size_t TL_AP = 0;
constexpr size_t TL_BB = TL_AP + (size_t)16 * 2 * 64 * 33 * 2;
constexpr size_t TL_KT = TL_BB + (size_t)16 * 2 * 64 * 16 * 2;
constexpr size_t TL_END = TL_KT + (size_t)16 * 2 * 32 * 256;

constexpr size_t WS_W = 0;
constexpr size_t WS_T = al256(WS_W + 2 * WL_END * 2);
constexpr size_t WS_MOD = al256(WS_T + 2 * TL_END * 4);
constexpr size_t WS_ROPE = al256(WS_MOD + (size_t)2 * 33 * 6144 * 4);
constexpr size_t WS_CTX = al256(WS_ROPE + (size_t)2048 * 24 * 2 * 4);
constexpr size_t WS_XN = al256(WS_CTX + (size_t)8192 * 1024 * 4);
constexpr size_t ST_ELEMS = (size_t)2 * 32 * 4 * 2 * 36 * 4608;
constexpr size_t WS_ST = WS_XN;
constexpr size_t WS_DEC = al256(WS_XN + ST_ELEMS * 2);
constexpr size_t WS_R1 = al256(WS_DEC + (size_t)2 * 32 * 36 * 4 * 2 * 48 * 4);
constexpr size_t WS_PM = WS_R1;
constexpr size_t WS_UH = al256(WS_PM + (size_t)MROWS * PMLD * 2);
constexpr size_t WS_YB = WS_R1;
constexpr size_t WS_H = WS_R1;
constexpr size_t WS_R2 = al256(WS_R1 + (size_t)MROWS * 3072 * 2);
constexpr size_t WS_Y = WS_R2;
constexpr size_t WS_M1 = WS_R1 + (size_t)64 * 1024 * 1024;
constexpr size_t WS_Y5 = al256(WS_R2 + (size_t)MROWS * 1024 * 2);
constexpr size_t WS_SS = al256(WS_Y5 + (size_t)MROWS * 256 * 2);
constexpr size_t WS_BAR = al256(WS_SS + (size_t)16 * 2304 * 256 * 4);
constexpr size_t BAR_BYTES = 3456 * 4;
constexpr size_t WS_EX = al256(WS_BAR + BAR_BYTES);
constexpr size_t WS_END = al256(WS_EX + (size_t)MROWS * 384 * 2);
static_assert(WS_UH + (size_t)16 * 2304 * 768 * 2 <= WS_R2, "R1 overflow");

typedef __bf16 bf16v2_t __attribute__((ext_vector_type(2)));
typedef float f32v2_t __attribute__((ext_vector_type(2)));
__device__ __forceinline__ unsigned pk2(float lo, float hi) { const f32v2_t v = {lo, hi}; const bf16v2_t b = __builtin_convertvector(v, bf16v2_t); return __builtin_bit_cast(unsigned, b); }
__device__ __forceinline__ bf16_t f2bf(float f) { return (bf16_t)(pk2(f, 0.f) & 0xffffu); }
__device__ __forceinline__ float bf2f(unsigned v) { return __uint_as_float(v << 16); }
__device__ __forceinline__ float bflo(unsigned w) { return __uint_as_float(w << 16); }
__device__ __forceinline__ float bfhi(unsigned w) { return __uint_as_float(w & 0xffff0000u); }
__device__ __forceinline__ void unpack8(const u32x4 w, float (&f)[8]) { f[0] = bflo(w.x); f[1] = bfhi(w.x); f[2] = bflo(w.y); f[3] = bfhi(w.y); f[4] = bflo(w.z); f[5] = bfhi(w.z); f[6] = bflo(w.w); f[7] = bfhi(w.w); }
__device__ __forceinline__ float sigmoidf_(float x) { return 1.0f / (1.0f + __expf(-x)); }
__device__ __forceinline__ float siluf_(float x) { return x / (1.0f + __expf(-x)); }
__device__ __forceinline__ float geluf_(float x) { const float z = 1.5957691216057308f * (x + 0.044715f * x * x * x); return x / (1.0f + __expf(-z)); }
__device__ __forceinline__ float wave_sum(float v) {
#pragma unroll
    for (int o = 1; o < 64; o <<= 1) v += __shfl_xor(v, o);
    return v;
}
#define GSYNC() do { asm volatile("s_waitcnt vmcnt(0) lgkmcnt(0)" ::: "memory"); grid.sync(); } while (0)
__device__ __forceinline__ size_t pm_off(size_t row, int col) { return (((row >> 6) * (size_t)(PMLD / 8) + (size_t)(col >> 3)) << 9) + ((row & 63) << 3) + (size_t)(col & 7); }
__device__ __forceinline__ size_t ex_off(size_t row, int col) { return (((row >> 6) * (size_t)48 + (size_t)(col >> 3)) << 9) + ((row & 63) << 3) + (size_t)(col & 7); }
#define LDS_WAIT() asm volatile("s_waitcnt lgkmcnt(0)" ::: "memory")
__device__ __forceinline__ int fresh_tid() { int t = threadIdx.x; asm volatile("" : "+v"(t)); return t; }

#define XB_TMO      128
#define XB_XCNT(j)  (256  + 64 * (j))
#define XB_XSUB(j)  (1280 + 64 * (j))
#define XB_XGEN(j)  (2304 + 64 * (j))
#define XB_TOP      3328
#define XB_TOPGEN   3392
#define XCD_BAR_WORDS 3456
#define XB_SPIN_CAP (1u << 18)

__device__ __forceinline__ unsigned xb_ld(unsigned* p)              { return __hip_atomic_load(p, __ATOMIC_RELAXED, __HIP_MEMORY_SCOPE_AGENT); }
__device__ __forceinline__ unsigned xb_add(unsigned* p, unsigned v) { return __hip_atomic_fetch_add(p, v, __ATOMIC_RELAXED, __HIP_MEMORY_SCOPE_AGENT); }
__device__ __forceinline__ unsigned xb_xcc_id() { return (unsigned)__builtin_amdgcn_s_getreg((3 << 11) | 20) & 0xFu; }
#define XB_SPIN(cond, bar) do { unsigned _sp = 0; while (cond) { __builtin_amdgcn_s_sleep(1); \
    if ((++_sp & 255u) == 0u) { if (xb_ld(&(bar)[XB_TMO])) break; if (_sp > XB_SPIN_CAP) { atomicAdd(&(bar)[XB_TMO], 1u); break; } } } } while (0)

struct XcdBarrier {
    unsigned* bar; unsigned x;
    volatile LAS unsigned* st;
};

__device__ __forceinline__ XcdBarrier xcd_barrier_post(unsigned* bar, volatile LAS unsigned* st) {
    XcdBarrier b; b.bar = bar; b.x = xb_xcc_id(); b.st = st;
    if (threadIdx.x == 0) (void)xb_add(&bar[XB_XCNT(b.x)], 1u);
    return b;
}
__device__ __forceinline__ void xcd_barrier_complete(unsigned* bar, unsigned x, unsigned& nloc, unsigned& nx) {
    const unsigned G = gridDim.x * gridDim.y * gridDim.z;
    unsigned sum, cnt, mine, sp = 0u;
    for (;;) {
        sum = 0u; cnt = 0u; mine = 0u;
#pragma unroll
        for (unsigned j = 0; j < 16; ++j) { const unsigned c = xb_ld(&bar[XB_XCNT(j)]); sum += c; cnt += (c > 0u) ? 1u : 0u; mine = (j == x) ? c : mine; }
        if (sum == G) break;
        __builtin_amdgcn_s_sleep(1);
        if ((++sp & 255u) == 0u) { if (xb_ld(&bar[XB_TMO])) break; if (sp > XB_SPIN_CAP) { atomicAdd(&bar[XB_TMO], 1u); break; } }
    }
    nloc = mine > 0u ? mine : 1u; nx = cnt > 0u ? cnt : 1u;
}

__device__ __forceinline__ void xcd_barrier(const XcdBarrier& b) {
    asm volatile("s_waitcnt vmcnt(0)" ::: "memory");
    __syncthreads();
    if (threadIdx.x == 0) {
        unsigned* bar = b.bar;
        __builtin_amdgcn_s_waitcnt(0);
        unsigned nloc = b.st[0], nx = b.st[1];
        if (nloc == 0u) { xcd_barrier_complete(bar, b.x, nloc, nx); b.st[0] = nloc; b.st[1] = nx; }
        const unsigned old = xb_add(&bar[XB_XSUB(b.x)], 1u);
        const unsigned gen = old / nloc;
        if (old + 1u == (gen + 1u) * nloc) {
            __builtin_amdgcn_fence(__ATOMIC_RELEASE, "agent");
            asm volatile("s_waitcnt vmcnt(0)" ::: "memory");
            const unsigned og = xb_add(&bar[XB_TOP], 1u);
            const unsigned tg = og / nx;
            if (og + 1u == (tg + 1u) * nx) xb_add(&bar[XB_TOPGEN], 1u);
            else XB_SPIN(xb_ld(&bar[XB_TOPGEN]) == tg, bar);
            __builtin_amdgcn_fence(__ATOMIC_ACQUIRE, "agent");
            xb_add(&bar[XB_XGEN(b.x)], 1u);
            asm volatile("s_waitcnt vmcnt(0)" ::: "memory");
        } else {
            XB_SPIN(xb_ld(&bar[XB_XGEN(b.x)]) == gen, bar);
            __builtin_amdgcn_fence(__ATOMIC_ACQUIRE, "agent");
            asm volatile("s_waitcnt vmcnt(0)" ::: "memory");
        }
    }
    __syncthreads();
}

namespace pg8 {
constexpr int BM = 256, BK = 64, HALF = 128, HTB = HALF * BK * 2, STAGE_BYTES = 8 * HTB, NXCD = 8, WGM = 4;
__device__ __forceinline__ int lds_byte(int r, int c) { const int st = (r >> 4) * 2 + (c >> 5), rr = r & 15, cc = c & 31, ob = rr * 64 + cc * 2; return st * 1024 + (ob ^ (((ob >> 9) & 1) << 5)); }
__device__ __forceinline__ void stage_rc(int b, int& R, int& C) { const int st = b / 1024, sb = b % 1024, swz = sb ^ (((sb >> 9) & 1) << 5); R = (st >> 1) * 16 + swz / 64; C = (st & 1) * 32 + (swz % 64) / 2; }
__device__ __forceinline__ int perm32(int rho) { const int n = rho >> 4, i = rho & 15; return 8 * (i >> 2) + 4 * n + (i & 3); }
struct Unit { int pm, pn, aux, nt; const char* A; const char* B; };
__device__ __forceinline__ void tile_map(int L, int nM, int nN, int& pm, int& pn) {
    const int nwg = nM * nN; int wgid = L;
    { const int q = nwg / NXCD, r = nwg % NXCD, xcd = wgid % NXCD, off = wgid / NXCD; wgid = (xcd < r ? xcd * (q + 1) : r * (q + 1) + (xcd - r) * q) + off; }
    const int nig = WGM * nN, gid = wgid / nig, fm = gid * WGM, gsz = (nM - fm) < WGM ? (nM - fm) : WGM;
    pm = fm + ((wgid % nig) % gsz); pn = (wgid % nig) / gsz;
}
template <class Epi, class Sched>
__device__ __forceinline__ void gemm_phase(LAS unsigned char* lds, const int lda, const int ldb, const Sched& S, const Epi& E) {
    int tid = threadIdx.x; asm volatile("" : "+v"(tid));
    const int wid = __builtin_amdgcn_readfirstlane(tid >> 6), lane = tid & 63, wr = wid >> 2, wc = wid & 3, fr = lane & 15, fq = lane >> 4;
    unsigned voffA[2], voffB[2];
#pragma unroll
    for (int i = 0; i < 2; ++i) { int R, C; stage_rc(tid * 16 + i * 8192, R, C); const int Rb = Epi::PERM ? ((R & ~31) + perm32(R & 31)) : R;
        voffA[i] = (unsigned)(R * lda + C) * 2u; voffB[i] = (unsigned)(Rb * ldb + C) * 2u; }
    const size_t kstep = (size_t)(BK * 2);
    const size_t hstepA = (size_t)HALF * lda * 2, hstepB = (size_t)HALF * ldb * 2;
    const unsigned ldsw = (unsigned)wid * 1024u;
    const int aoff = lds_byte(wr * 64 + fr, fq * 8), boff = lds_byte(wc * 32 + fr, fq * 8);
#define PG8_SA(b, h) (((b) * 2 + (h)) * HTB)
#define PG8_SB(b, h) ((4 + (b) * 2 + (h)) * HTB)
#define PG8_STAGE(bufoff, gbase, voff) do { _Pragma("unroll") for (int _i = 0; _i < 2; ++_i) \
        __builtin_amdgcn_global_load_lds((const unsigned*)((const char*)(gbase) + (voff)[_i]), (LAS unsigned*)(lds + (bufoff) + ldsw + _i * 8192), 16, 0, 0); } while (0)
#define PG8_LDA(dst, b, h) do { _Pragma("unroll") for (int m = 0; m < 4; ++m) _Pragma("unroll") for (int k = 0; k < 2; ++k) dst[m][k] = *(const LAS bf16x8*)(lds + PG8_SA(b, h) + aoff + m * 2048 + k * 1024); } while (0)
#define PG8_LDB(dst, b, h) do { _Pragma("unroll") for (int n = 0; n < 2; ++n) _Pragma("unroll") for (int k = 0; k < 2; ++k) dst[n][k] = *(const LAS bf16x8*)(lds + PG8_SB(b, h) + boff + n * 2048 + k * 1024); } while (0)
#define PG8_MMA(ai, bj, At, Bt) do { __builtin_amdgcn_s_setprio(1); _Pragma("unroll") for (int m = 0; m < 4; ++m) _Pragma("unroll") for (int n = 0; n < 2; ++n) _Pragma("unroll") for (int k = 0; k < 2; ++k) \
        acc[ai][bj][m][n] = __builtin_amdgcn_mfma_f32_16x16x32_bf16(Bt[n][k], At[m][k], acc[ai][bj][m][n], 0, 0, 0); __builtin_amdgcn_s_setprio(0); } while (0)
#define PG8_WAIT_V(n) asm volatile("s_waitcnt vmcnt(" #n ")" ::: "memory")
#define PG8_WAIT_L(n) asm volatile("s_waitcnt lgkmcnt(" #n ")" ::: "memory")
#define PG8_BAR __builtin_amdgcn_s_barrier()
#define PG8_SCHED __builtin_amdgcn_sched_barrier(0)
    Unit cur, nxt; int ui = 0;
    if (!S.next(0, cur)) return;
    f32x4 acc[2][2][4][2];
#pragma unroll
    for (int a = 0; a < 2; ++a)
#pragma unroll
        for (int b = 0; b < 2; ++b)
#pragma unroll
            for (int m = 0; m < 4; ++m)
#pragma unroll
                for (int n = 0; n < 2; ++n) acc[a][b][m][n] = (f32x4){0.f, 0.f, 0.f, 0.f};
    bf16x8 At[4][2], B0[2][2], B1[2][2];
    const char* cA = cur.A; const char* cB = cur.B;
    PG8_STAGE(PG8_SB(0, 0), cB, voffB); PG8_STAGE(PG8_SA(0, 0), cA, voffA); PG8_STAGE(PG8_SB(0, 1), cB + hstepB, voffB); PG8_STAGE(PG8_SA(0, 1), cA + hstepA, voffA);
    if (wr == 1) PG8_BAR;
    PG8_WAIT_V(4); PG8_BAR;
    PG8_STAGE(PG8_SB(1, 0), cB + kstep, voffB); PG8_STAGE(PG8_SA(1, 0), cA + kstep, voffA); PG8_STAGE(PG8_SB(1, 1), cB + hstepB + kstep, voffB);
    PG8_WAIT_V(6); PG8_BAR;
    for (;;) {
        const bool has_next = S.next(ui + 1, nxt);
        const char* nA = has_next ? nxt.A : cA; const char* nB = has_next ? nxt.B : cB;
        const int nt = cur.nt;
        for (int t = 0; t < nt; t += 2) {
            const bool last = (t == nt - 2);
            const char* a1 = cA + (size_t)(t + 1) * kstep;
            const char* a2 = last ? nA : cA + (size_t)(t + 2) * kstep; const char* b2 = last ? nB : cB + (size_t)(t + 2) * kstep;
            const char* a3 = a2 + kstep; const char* b3 = b2 + kstep;
            PG8_LDB(B0, 0, 0); PG8_SCHED; PG8_LDA(At, 0, 0); PG8_STAGE(PG8_SA(1, 1), a1 + hstepA, voffA);
            PG8_WAIT_L(8); PG8_BAR; PG8_WAIT_L(0); PG8_MMA(0, 0, At, B0); PG8_BAR; PG8_SCHED;
            PG8_LDB(B1, 0, 1); PG8_STAGE(PG8_SB(0, 0), b2, voffB);
            PG8_BAR; PG8_WAIT_L(0); PG8_MMA(0, 1, At, B1); PG8_BAR;
            PG8_LDA(At, 0, 1); PG8_STAGE(PG8_SA(0, 0), a2, voffA);
            PG8_BAR; PG8_WAIT_L(0); PG8_MMA(1, 0, At, B0); PG8_BAR; PG8_SCHED;
            PG8_STAGE(PG8_SB(0, 1), b2 + hstepB, voffB);
            PG8_WAIT_V(6); PG8_BAR; PG8_MMA(1, 1, At, B1); PG8_BAR;
            PG8_LDB(B0, 1, 0); PG8_SCHED; PG8_LDA(At, 1, 0); PG8_STAGE(PG8_SA(0, 1), a2 + hstepA, voffA);
            PG8_WAIT_L(8); PG8_BAR; PG8_WAIT_L(0); PG8_MMA(0, 0, At, B0); PG8_BAR; PG8_SCHED;
            PG8_LDB(B1, 1, 1); PG8_STAGE(PG8_SB(1, 0), b3, voffB);
            PG8_BAR; PG8_WAIT_L(0); PG8_MMA(0, 1, At, B1); PG8_BAR;
            PG8_LDA(At, 1, 1); PG8_STAGE(PG8_SA(1, 0), a3, voffA);
            PG8_BAR; PG8_WAIT_L(0); PG8_MMA(1, 0, At, B0); PG8_BAR; PG8_SCHED;
            PG8_STAGE(PG8_SB(1, 1), b3 + hstepB, voffB);
            PG8_WAIT_V(6); PG8_BAR; PG8_MMA(1, 1, At, B1); PG8_BAR;
        }
        E(acc, cur, wr, wc, fr, fq);
        if (!has_next) break;
#pragma unroll
        for (int a = 0; a < 2; ++a)
#pragma unroll
            for (int b = 0; b < 2; ++b)
#pragma unroll
                for (int m = 0; m < 4; ++m)
#pragma unroll
                    for (int n = 0; n < 2; ++n) acc[a][b][m][n] = (f32x4){0.f, 0.f, 0.f, 0.f};
        cur = nxt; cA = nA; cB = nB; ++ui;
    }
    PG8_WAIT_V(0);
    if (wr == 0) PG8_BAR;
    PG8_BAR;
#undef PG8_SA
#undef PG8_SB
#undef PG8_STAGE
#undef PG8_LDA
#undef PG8_LDB
#undef PG8_MMA
#undef PG8_WAIT_V
#undef PG8_WAIT_L
#undef PG8_BAR
#undef PG8_SCHED
}
}
using pg8::Unit;

struct SchedPlain {
    const char* A; const char* B; size_t astep, bstep; int nM, nN, nt, G, c, skip;
    __device__ __forceinline__ bool next(int i, Unit& u) const {
        const long L = (long)i * G + c; if (L >= (long)nM * nN) return false;
        pg8::tile_map((int)L, nM, nN, u.pm, u.pn); if (skip) u.pm += (u.pm >> 3) + 1; u.A = A + (size_t)u.pm * astep; u.B = B + (size_t)u.pn * bstep; u.nt = nt; u.aux = 0; return true;
    }
};
struct SchedBranch {
    const char* A; const char* B; int G, c, nM, skip;
    __device__ __forceinline__ bool next(int i, Unit& u) const {
        const long L = (long)i * G + c; if (L >= 3 * nM * 4) return false;
        const int b = (int)(L / (nM * 4)), rem = (int)(L % (nM * 4));
        pg8::tile_map(rem, nM, 4, u.pm, u.pn); if (skip) u.pm += (u.pm >> 3) + 1;
        const int koff = b == 0 ? 0 : (b == 1 ? 256 : 640);
        u.A = A + ((size_t)u.pm * 256 * 1024 + koff) * 2; u.B = B + ((size_t)u.pn * 256 * 1024 + koff) * 2; u.nt = b == 0 ? 4 : 6; u.aux = b; return true;
    }
};
struct SchedGate {
    const char* A; const char* B; int G, c, nM, skip;
    __device__ __forceinline__ bool next(int i, Unit& u) const {
        const int j = i / 3, b = i - 3 * j; const long L = (long)j * G + c; if (L >= nM * 4) return false;
        pg8::tile_map((int)L, nM, 4, u.pm, u.pn); if (skip) u.pm += (u.pm >> 3) + 1;
        u.A = A + (size_t)u.pm * 256 * 1024 * 2; u.B = B + (size_t)(b * 4 + u.pn) * 256 * 1024 * 2; u.nt = 16; u.aux = b; return true;
    }
};
struct SchedMerge {
    const char* Y; const char* Wbr; const char* XN; const char* Wg; int G, c, nM, skip;
    __device__ __forceinline__ bool next(int i, Unit& u) const {
        const int j = i / 6, sub = i - 6 * j, b = sub >> 1, kind = sub & 1; const long L = (long)j * G + c; if (L >= nM * 4) return false;
        pg8::tile_map((int)L, nM, 4, u.pm, u.pn); if (skip) u.pm += (u.pm >> 3) + 1;
        u.aux = sub;
        if (kind == 0) { const int koff = b == 0 ? 0 : (b == 1 ? 256 : 640);
            u.A = Y + ((size_t)u.pm * 256 * 1024 + koff) * 2; u.B = Wbr + ((size_t)u.pn * 256 * 1024 + koff) * 2; u.nt = b == 0 ? 4 : 6; }
        else { u.A = XN + (size_t)u.pm * 256 * 1024 * 2; u.B = Wg + (size_t)(b * 4 + u.pn) * 256 * 1024 * 2; u.nt = 16; }
        return true;
    }
};
struct SchedInProjLast {
    const char* A; const char* B; int G, c;
    __device__ __forceinline__ bool next(int i, Unit& u) const {
        const long L = (long)i * G + c; if (L >= 256 * 11 + 32 * 8) return false;
        if (L < 256 * 11) { pg8::tile_map((int)L, 256, 11, u.pm, u.pn); u.pm += (u.pm >> 3) + 1; }
        else { const int idx = (int)L - 256 * 11, b = idx >> 3, j = idx & 7; u.pm = 9 * b; u.pn = j < 4 ? j : (j < 7 ? j + 2 : 10); }
        u.A = A + (size_t)u.pm * 256 * 1024 * 2; u.B = B + (size_t)u.pn * 256 * 1024 * 2; u.nt = 16; u.aux = 0; return true;
    }
};
struct SchedS5 {
    const char* A; const char* B; int nN, ldb, nt, G, c;
    __device__ __forceinline__ bool next(int i, Unit& u) const {
        const long L = (long)i * G + c; if (L >= 16 * 9 * nN) return false;
        const int g = (int)L / (9 * nN), rem = (int)L % (9 * nN); u.pm = rem / nN; u.pn = rem % nN; u.aux = g;
        u.A = A + ((size_t)g * 2304 + u.pm * 256) * 768 * 2; u.B = B + ((size_t)g * nN * 256 + u.pn * 256) * ldb * 2; u.nt = nt; return true;
    }
};

#define EPI_ARGS const f32x4 (&acc)[2][2][4][2], const Unit& u, int wr, int wc, int fr, int fq
__device__ __forceinline__ u32x4 pack8(const f32x4 a, const f32x4 b) { u32x4 w; w.x = pk2(a[0], a[1]); w.y = pk2(a[2], a[3]); w.z = pk2(b[0], b[1]); w.w = pk2(b[2], b[3]); return w; }

struct EpiInProj {
    static constexpr bool PERM = true;
    bf16_t* PM; bf16_t* UH;
    __device__ __forceinline__ void operator()(EPI_ARGS) const {
        const int row0 = u.pm * 256 + wr * 64 + fr, ct0 = wc * 32 + 8 * fq;
#pragma unroll
        for (int ai = 0; ai < 2; ++ai)
#pragma unroll
            for (int m = 0; m < 4; ++m) { const int row = row0 + ai * 128 + m * 16;
#pragma unroll
                for (int bj = 0; bj < 2; ++bj) { const int ct = ct0 + bj * 128; const u32x4 w = pack8(acc[ai][bj][m][0], acc[ai][bj][m][1]);
                    bf16_t* dst = (u.pn == 0) ? UH + ((size_t)(ct >> 4) * 2304 + (row >> 5)) * 768 + (row & 31) * 16 + (ct & 15)
                                              : PM + pm_off((size_t)row, (u.pn - 1) * 256 + ct);
                    *(u32x4*)dst = w; } }
    }
};
struct EpiS5State {
    static constexpr bool PERM = false;
    float* SS;
    __device__ __forceinline__ void operator()(EPI_ARGS) const {
        const int row0 = u.pm * 256 + wr * 64 + fr, col0 = wc * 32 + 4 * fq;
        float* base = SS + (size_t)u.aux * 2304 * 256;
#pragma unroll
        for (int ai = 0; ai < 2; ++ai)
#pragma unroll
            for (int m = 0; m < 4; ++m) { float* rowp = base + (size_t)(row0 + ai * 128 + m * 16) * 256 + col0;
#pragma unroll
                for (int bj = 0; bj < 2; ++bj)
#pragma unroll
                    for (int n = 0; n < 2; ++n) *(f32x4*)(rowp + bj * 128 + n * 16) = acc[ai][bj][m][n]; }
    }
};
struct EpiS5Out {
    static constexpr bool PERM = true;
    bf16_t* Y5;
    __device__ __forceinline__ void operator()(EPI_ARGS) const {
        const int row0 = u.pm * 256 + wr * 64 + fr, ct0 = u.pn * 256 + wc * 32 + 8 * fq, g = u.aux;
#pragma unroll
        for (int ai = 0; ai < 2; ++ai)
#pragma unroll
            for (int m = 0; m < 4; ++m) { const int R = row0 + ai * 128 + m * 16;
#pragma unroll
                for (int bj = 0; bj < 2; ++bj) { const int n = ct0 + bj * 128; const int t = n >> 4, c = n & 15;
                    f32x4 a = acc[ai][bj][m][0], b = acc[ai][bj][m][1];
#pragma unroll
                    for (int j = 0; j < 4; ++j) { a[j] = geluf_(a[j]); b[j] = geluf_(b[j]); }
                    *(u32x4*)(Y5 + ((size_t)R * 32 + t) * 256 + g * 16 + c) = pack8(a, b); } }
    }
};
struct EpiGlu {
    static constexpr bool PERM = true;
    const bf16_t* Y5; bf16_t* Y; const float* gb;
    __device__ __forceinline__ void operator()(EPI_ARGS) const {
        const int row0 = u.pm * 256 + wr * 64 + fr, ct0 = wc * 32 + 8 * fq;
        f32x4 bia[2][2];
#pragma unroll
        for (int bj = 0; bj < 2; ++bj) { bia[bj][0] = *(const f32x4*)(gb + ct0 + bj * 128); bia[bj][1] = *(const f32x4*)(gb + ct0 + bj * 128 + 4); }
#pragma unroll
        for (int ai = 0; ai < 2; ++ai) { u32x4 yv[8];
#pragma unroll
            for (int m = 0; m < 4; ++m)
#pragma unroll
                for (int bj = 0; bj < 2; ++bj) yv[m * 2 + bj] = *(const u32x4*)(Y5 + (size_t)(row0 + ai * 128 + m * 16) * 256 + ct0 + bj * 128);
#pragma unroll
            for (int m = 0; m < 4; ++m)
#pragma unroll
                for (int bj = 0; bj < 2; ++bj) { const int row = row0 + ai * 128 + m * 16, c = ct0 + bj * 128; const u32x4 y4 = yv[m * 2 + bj];
                    f32x4 a = acc[ai][bj][m][0] + bia[bj][0], b = acc[ai][bj][m][1] + bia[bj][1];
                    a[0] = bflo(y4.x) * sigmoidf_(a[0]); a[1] = bfhi(y4.x) * sigmoidf_(a[1]); a[2] = bflo(y4.y) * sigmoidf_(a[2]); a[3] = bfhi(y4.y) * sigmoidf_(a[3]);
                    b[0] = bflo(y4.z) * sigmoidf_(b[0]); b[1] = bfhi(y4.z) * sigmoidf_(b[1]); b[2] = bflo(y4.w) * sigmoidf_(b[2]); b[3] = bfhi(y4.w) * sigmoidf_(b[3]);
                    *(u32x4*)(Y + (size_t)row * 1024 + c) = pack8(a, b); } }
    }
};
struct EpiBranch {
    static constexpr bool PERM = true;
    bf16_t* YB;
    __device__ __forceinline__ void operator()(EPI_ARGS) const {
        const int row0 = u.pm * 256 + wr * 64 + fr, ct0 = u.aux * 1024 + u.pn * 256 + wc * 32 + 8 * fq;
#pragma unroll
        for (int ai = 0; ai < 2; ++ai)
#pragma unroll
            for (int m = 0; m < 4; ++m) { const int row = row0 + ai * 128 + m * 16;
#pragma unroll
                for (int bj = 0; bj < 2; ++bj) *(u32x4*)(YB + (size_t)row * 3072 + ct0 + bj * 128) = pack8(acc[ai][bj][m][0], acc[ai][bj][m][1]); }
    }
};
struct EpiGate {
    static constexpr bool PERM = true;
    const bf16_t* YB; bf16_t* M1;
    __device__ __forceinline__ void operator()(EPI_ARGS) const {
        const int row0 = u.pm * 256 + wr * 64 + fr, ct0 = u.pn * 256 + wc * 32 + 8 * fq, b = u.aux;
#pragma unroll
        for (int ai = 0; ai < 2; ++ai)
#pragma unroll
            for (int m = 0; m < 4; ++m) { const int row = row0 + ai * 128 + m * 16;
#pragma unroll
                for (int bj = 0; bj < 2; ++bj) { const int c = ct0 + bj * 128;
                    const u32x4 yv = *(const u32x4*)(YB + (size_t)row * 3072 + b * 1024 + c);
                    bf16_t* mp = M1 + (size_t)row * 1024 + c;
                    f32x4 p = acc[ai][bj][m][0], q = acc[ai][bj][m][1];
                    p[0] = bflo(yv.x) * sigmoidf_(p[0]); p[1] = bfhi(yv.x) * sigmoidf_(p[1]); p[2] = bflo(yv.y) * sigmoidf_(p[2]); p[3] = bfhi(yv.y) * sigmoidf_(p[3]);
                    q[0] = bflo(yv.z) * sigmoidf_(q[0]); q[1] = bfhi(yv.z) * sigmoidf_(q[1]); q[2] = bflo(yv.w) * sigmoidf_(q[2]); q[3] = bfhi(yv.w) * sigmoidf_(q[3]);
                    if (b != 0) { const u32x4 mv = *(const u32x4*)mp;
                        p[0] += bflo(mv.x); p[1] += bfhi(mv.x); p[2] += bflo(mv.y); p[3] += bfhi(mv.y);
                        q[0] += bflo(mv.z); q[1] += bfhi(mv.z); q[2] += bflo(mv.w); q[3] += bfhi(mv.w); }
                    *(u32x4*)mp = pack8(p, q); } }
    }
};
struct EpiMerge {
    static constexpr bool PERM = true;
    bf16_t* scr; bf16_t* M1;
    __device__ __forceinline__ void operator()(EPI_ARGS) const {
        const int b = u.aux >> 1, kind = u.aux & 1;
        int frl = fr, fql = fq; asm volatile("" : "+v"(frl), "+v"(fql));
        const int rt0 = wr * 64 + frl, ct0 = wc * 32 + 8 * fql;
        bf16_t* s1 = scr + rt0 * 256 + ct0; bf16_t* s2 = s1 + 65536;
        if (kind == 0) {
#pragma unroll
            for (int ai = 0; ai < 2; ++ai)
#pragma unroll
                for (int m = 0; m < 4; ++m)
#pragma unroll
                    for (int bj = 0; bj < 2; ++bj) *(u32x4*)(s1 + (ai * 128 + m * 16) * 256 + bj * 128) = pack8(acc[ai][bj][m][0], acc[ai][bj][m][1]);
        } else {
            bf16_t* dbase; int dld;
            if (b == 2) { dbase = M1 + (size_t)(u.pm * 256 + rt0) * 1024 + u.pn * 256 + ct0; dld = 1024; } else { dbase = s2; dld = 256; }
#pragma unroll
            for (int ai = 0; ai < 2; ++ai) {
                u32x4 yv[8], mvv[8];
#pragma unroll
                for (int m = 0; m < 4; ++m)
#pragma unroll
                    for (int bj = 0; bj < 2; ++bj) { const int off = (ai * 128 + m * 16) * 256 + bj * 128; yv[m * 2 + bj] = *(const u32x4*)(s1 + off);
                        mvv[m * 2 + bj] = (b != 0) ? *(const u32x4*)(s2 + off) : (u32x4){0u, 0u, 0u, 0u}; }
#pragma unroll
                for (int m = 0; m < 4; ++m)
#pragma unroll
                    for (int bj = 0; bj < 2; ++bj) { const int ro = ai * 128 + m * 16; const u32x4 y4 = yv[m * 2 + bj], m4 = mvv[m * 2 + bj];
                        f32x4 p = acc[ai][bj][m][0], q = acc[ai][bj][m][1];
                        p[0] = bflo(y4.x) * sigmoidf_(p[0]) + bflo(m4.x); p[1] = bfhi(y4.x) * sigmoidf_(p[1]) + bfhi(m4.x); p[2] = bflo(y4.y) * sigmoidf_(p[2]) + bflo(m4.y); p[3] = bfhi(y4.y) * sigmoidf_(p[3]) + bfhi(m4.y);
                        q[0] = bflo(y4.z) * sigmoidf_(q[0]) + bflo(m4.z); q[1] = bfhi(y4.z) * sigmoidf_(q[1]) + bfhi(m4.z); q[2] = bflo(y4.w) * sigmoidf_(q[2]) + bflo(m4.w); q[3] = bfhi(y4.w) * sigmoidf_(q[3]) + bfhi(m4.w);
                        *(u32x4*)(dbase + (size_t)ro * dld + bj * 128) = pack8(p, q); }
            }
        }
    }
};
struct EpiResid {
    static constexpr bool PERM = false;
    const float* slat; const float* sctx; float* dlat; float* dctx; const float* mod;
    __device__ __forceinline__ void operator()(EPI_ARGS) const {
        const int b = u.pm / 9, j = u.pm - 9 * b;
        const size_t tbase = (j == 0) ? (size_t)b * 256 * 1024 : ((size_t)b * 2048 + (size_t)(j - 1) * 256) * 1024;
        const int r0 = wr * 64 + fr, col0 = u.pn * 256 + wc * 32 + 4 * fq;
        const float* src = ((j == 0) ? sctx : slat) + tbase + (size_t)r0 * 1024 + col0; float* dst = ((j == 0) ? dctx : dlat) + tbase + (size_t)r0 * 1024 + col0;
        const float* mp = mod + (size_t)((j == 0) ? 32 : b) * 6144 + col0;
        f32x4 mv[2][2];
#pragma unroll
        for (int bj = 0; bj < 2; ++bj)
#pragma unroll
            for (int n = 0; n < 2; ++n) mv[bj][n] = *(const f32x4*)(mp + bj * 128 + n * 16);
        f32x4 xa[8], xb[8];
#define RES_LOAD(buf, g) do { _Pragma("unroll") for (int mm = 0; mm < 2; ++mm) _Pragma("unroll") for (int bj = 0; bj < 2; ++bj) _Pragma("unroll") for (int n = 0; n < 2; ++n) \
            buf[mm * 4 + bj * 2 + n] = *(const f32x4*)(src + (size_t)(((g) >> 1) * 128 + (2 * ((g) & 1) + mm) * 16) * 1024 + bj * 128 + n * 16); } while (0)
#define RES_STORE(buf, g) do { _Pragma("unroll") for (int mm = 0; mm < 2; ++mm) _Pragma("unroll") for (int bj = 0; bj < 2; ++bj) _Pragma("unroll") for (int n = 0; n < 2; ++n) \
            *(f32x4*)(dst + (size_t)(((g) >> 1) * 128 + (2 * ((g) & 1) + mm) * 16) * 1024 + bj * 128 + n * 16) = buf[mm * 4 + bj * 2 + n] + mv[bj][n] * acc[(g) >> 1][bj][2 * ((g) & 1) + mm][n]; } while (0)
        RES_LOAD(xa, 0); RES_LOAD(xb, 1);
        RES_STORE(xa, 0); RES_LOAD(xa, 2);
        RES_STORE(xb, 1); RES_LOAD(xb, 3);
        RES_STORE(xa, 2); RES_STORE(xb, 3);
#undef RES_LOAD
#undef RES_STORE
    }
};
template <bool BSRC> struct EpiResidMid {
    static constexpr bool PERM = false;
    const float* slat; const float* sctx; const bf16_t* xb; bf16_t* xmid; const float* mod;
    __device__ __forceinline__ void operator()(EPI_ARGS) const {
        const int b = u.pm / 9, j = u.pm - 9 * b;
        const size_t tbase = (j == 0) ? (size_t)b * 256 * 1024 : ((size_t)b * 2048 + (size_t)(j - 1) * 256) * 1024;
        const int r0 = wr * 64 + fr, col0 = u.pn * 256 + wc * 32 + 4 * fq;
        const size_t uoff = ((size_t)u.pm * 256 + r0) * 1024 + col0;
        const float* src = ((j == 0) ? sctx : slat) + tbase + (size_t)r0 * 1024 + col0;
        const bf16_t* srcb = xb + uoff;
        bf16_t* dst = xmid + uoff;
        const float* mp = mod + (size_t)((j == 0) ? 32 : b) * 6144 + col0;
        f32x4 mv[2][2];
#pragma unroll
        for (int bj = 0; bj < 2; ++bj)
#pragma unroll
            for (int n = 0; n < 2; ++n) mv[bj][n] = *(const f32x4*)(mp + bj * 128 + n * 16);
        f32x4 xa[8], xb_[8];
#define RES_LOAD(buf, g) do { _Pragma("unroll") for (int mm = 0; mm < 2; ++mm) _Pragma("unroll") for (int bj = 0; bj < 2; ++bj) _Pragma("unroll") for (int n = 0; n < 2; ++n) { \
            const size_t o_ = (size_t)(((g) >> 1) * 128 + (2 * ((g) & 1) + mm) * 16) * 1024 + bj * 128 + n * 16; \
            if (BSRC) { const u32x2 xw = *(const u32x2*)(srcb + o_); buf[mm * 4 + bj * 2 + n] = (f32x4){bflo(xw.x), bfhi(xw.x), bflo(xw.y), bfhi(xw.y)}; } \
            else buf[mm * 4 + bj * 2 + n] = *(const f32x4*)(src + o_); } } while (0)
#define RES_STORE(buf, g) do { _Pragma("unroll") for (int mm = 0; mm < 2; ++mm) _Pragma("unroll") for (int bj = 0; bj < 2; ++bj) _Pragma("unroll") for (int n = 0; n < 2; ++n) { \
            const f32x4 y = buf[mm * 4 + bj * 2 + n] + mv[bj][n] * acc[(g) >> 1][bj][2 * ((g) & 1) + mm][n]; u32x2 w; w.x = pk2(y[0], y[1]); w.y = pk2(y[2], y[3]); \
            *(u32x2*)(dst + (size_t)(((g) >> 1) * 128 + (2 * ((g) & 1) + mm) * 16) * 1024 + bj * 128 + n * 16) = w; } } while (0)
        RES_LOAD(xa, 0); RES_LOAD(xb_, 1);
        RES_STORE(xa, 0); RES_LOAD(xa, 2);
        RES_STORE(xb_, 1); RES_LOAD(xb_, 3);
        RES_STORE(xa, 2); RES_STORE(xb_, 3);
#undef RES_LOAD
#undef RES_STORE
    }
};
template <bool BOUT> struct EpiResidOut {
    static constexpr bool PERM = false;
    const bf16_t* xmid; float* dlat; bf16_t* xb; const float* mod;
    __device__ __forceinline__ void operator()(EPI_ARGS) const {
        const int b = u.pm / 9, j = u.pm - 9 * b;
        const int r0 = wr * 64 + fr, col0 = u.pn * 256 + wc * 32 + 4 * fq;
        const size_t uoff = ((size_t)u.pm * 256 + r0) * 1024 + col0;
        const bf16_t* src = xmid + uoff;
        float* dst = dlat + ((size_t)b * 2048 + (size_t)(j - 1) * 256 + r0) * 1024 + col0;
        bf16_t* dstb = xb + uoff;
        const float* mp = mod + (size_t)((j == 0) ? 32 : b) * 6144 + col0;
        f32x4 mv[2][2];
#pragma unroll
        for (int bj = 0; bj < 2; ++bj)
#pragma unroll
            for (int n = 0; n < 2; ++n) mv[bj][n] = *(const f32x4*)(mp + bj * 128 + n * 16);
        u32x2 xa[16], xc[16];
#define RES_LOAD(buf, h) do { _Pragma("unroll") for (int m = 0; m < 4; ++m) _Pragma("unroll") for (int bj = 0; bj < 2; ++bj) _Pragma("unroll") for (int n = 0; n < 2; ++n) \
            buf[m * 4 + bj * 2 + n] = *(const u32x2*)(src + (size_t)((h) * 128 + m * 16) * 1024 + bj * 128 + n * 16); } while (0)
#define RES_STORE(buf, h) do { _Pragma("unroll") for (int m = 0; m < 4; ++m) _Pragma("unroll") for (int bj = 0; bj < 2; ++bj) _Pragma("unroll") for (int n = 0; n < 2; ++n) { \
            const u32x2 xw = buf[m * 4 + bj * 2 + n]; const f32x4 xo = {bflo(xw.x), bfhi(xw.x), bflo(xw.y), bfhi(xw.y)}; const f32x4 y = xo + mv[bj][n] * acc[h][bj][m][n]; \
            const size_t o_ = (size_t)((h) * 128 + m * 16) * 1024 + bj * 128 + n * 16; \
            if (BOUT) { u32x2 w; w.x = pk2(y[0], y[1]); w.y = pk2(y[2], y[3]); *(u32x2*)(dstb + o_) = w; } else *(f32x4*)(dst + o_) = y; } } while (0)
        RES_LOAD(xa, 0); RES_LOAD(xc, 1);
        RES_STORE(xa, 0); RES_STORE(xc, 1);
#undef RES_LOAD
#undef RES_STORE
    }
};
struct EpiSwiglu {
    static constexpr bool PERM = true;
    bf16_t* H;
    __device__ __forceinline__ void operator()(EPI_ARGS) const {
        const int row0 = u.pm * 256 + wr * 64 + fr, c0 = u.pn * 128 + wc * 32 + 8 * fq;
#pragma unroll
        for (int ai = 0; ai < 2; ++ai)
#pragma unroll
            for (int m = 0; m < 4; ++m) { const int row = row0 + ai * 128 + m * 16;
                f32x4 a = acc[ai][0][m][0], b = acc[ai][0][m][1]; const f32x4 a2 = acc[ai][1][m][0], b2 = acc[ai][1][m][1];
#pragma unroll
                for (int j = 0; j < 4; ++j) { a[j] = siluf_(a[j]) * a2[j]; b[j] = siluf_(b[j]) * b2[j]; }
                *(u32x4*)(H + (size_t)row * FFH + c0) = pack8(a, b); }
    }
};

struct Params { const float* in[31]; float* out; unsigned char* ws; };

__device__ __forceinline__ void xpose_item(const float* W, int ldsrc, int k0, int c0, bf16_t* dst, int lddst, int r0, float scale, LAS float* scr, int lane) {
    float wv[32];
#pragma unroll
    for (int i = 0; i < 32; ++i) wv[i] = W[(size_t)(k0 + 2 * i + (lane >> 5)) * ldsrc + c0 + (lane & 31)];
#pragma unroll
    for (int i = 0; i < 32; ++i) scr[(2 * i + (lane >> 5)) * 33 + (lane & 31)] = wv[i];
    LDS_WAIT();
    const int c = lane & 7;
#pragma unroll
    for (int j = 0; j < 4; ++j) { const int n = (lane >> 3) + 8 * j; const LAS float* s = scr + (8 * c) * 33 + n;
        u32x4 o; o.x = pk2(s[0] * scale, s[33] * scale); o.y = pk2(s[2 * 33] * scale, s[3 * 33] * scale); o.z = pk2(s[4 * 33] * scale, s[5 * 33] * scale); o.w = pk2(s[6 * 33] * scale, s[7 * 33] * scale);
        *(u32x4*)(dst + (size_t)(r0 + n) * lddst + k0 + 8 * c) = o; }
    LDS_WAIT();
}
__device__ __forceinline__ void xpose_job(const float* W, int ldsrc, int K, int ncols, int srccol0, bf16_t* dst, int lddst, int dstrow0, float scale, int mode, int gw, int NGW, LAS float* scr, int lane) {
    const int nblk = ncols / 32, items = (K / 64) * nblk;
    for (int it = gw; it < items; it += NGW) { const int kb = it / nblk, nb = it - kb * nblk; int r0 = dstrow0 + 32 * nb, c0 = srccol0 + 32 * nb;
        if (mode == 1) { const int pn = r0 >> 8, within = r0 & 255; c0 = within < 128 ? 128 * pn + within : FFH + 128 * pn + within - 128; }
        xpose_item(W, ldsrc, 64 * kb, c0, dst, lddst, r0, scale, scr, lane); }
}

__device__ __forceinline__ void norm_mod_phase(const float* slat, const float* sctx, const float* gain, const float* modl, int ks, bf16_t* XN, int blk, int NGW, int skip) {
    const int tid = fresh_tid(), lane = tid & 63, gw = blk * 8 + __builtin_amdgcn_readfirstlane(tid >> 6);
    const int nrows = skip ? NB * SEQ : MROWS;
    for (int rowb = gw; rowb < nrows; rowb += 4 * NGW) {
        f32x4 v[4][4]; float ss[4];
#pragma unroll
        for (int q = 0; q < 4; ++q) { const int rr = rowb + q * NGW; const int row = skip ? (rr >> 11) * TOK + CTXL + (rr & 2047) : rr; const int b = row / TOK, pos = row - b * TOK;
            const float* src = pos < CTXL ? sctx + ((size_t)b * CTXL + pos) * D : slat + ((size_t)b * SEQ + pos - CTXL) * D;
#pragma unroll
            for (int j = 0; j < 4; ++j) v[q][j] = ((const f32x4*)src)[lane + 64 * j]; }
#pragma unroll
        for (int q = 0; q < 4; ++q) { float a = 0.f;
#pragma unroll
            for (int j = 0; j < 4; ++j) a += v[q][j][0] * v[q][j][0] + v[q][j][1] * v[q][j][1] + v[q][j][2] * v[q][j][2] + v[q][j][3] * v[q][j][3];
            ss[q] = a; }
#pragma unroll
        for (int o = 1; o < 64; o <<= 1) {
#pragma unroll
            for (int q = 0; q < 4; ++q) ss[q] += __shfl_xor(ss[q], o); }
#pragma unroll
        for (int q = 0; q < 4; ++q) { const int rr = rowb + q * NGW; const int row = skip ? (rr >> 11) * TOK + CTXL + (rr & 2047) : rr; const int b = row / TOK, pos = row - b * TOK;
            const float* sh = modl + (size_t)(pos < CTXL ? 32 : b) * 6144 + ks * 1024; const float* sc = sh + 1024;
            const float rstd = rsqrtf(ss[q] * (1.0f / D) + EPS);
#pragma unroll
            for (int j = 0; j < 4; ++j) { const int col = 4 * (lane + 64 * j);
                const f32x4 g4 = *(const f32x4*)(gain + col), s4 = *(const f32x4*)(sc + col), h4 = *(const f32x4*)(sh + col);
                f32x4 y;
#pragma unroll
                for (int e = 0; e < 4; ++e) y[e] = v[q][j][e] * rstd * g4[e] * (1.0f + s4[e]) + h4[e];
                u32x2 w; w.x = pk2(y[0], y[1]); w.y = pk2(y[2], y[3]);
                *(u32x2*)(XN + (size_t)row * D + col) = w; } }
    }
}
__device__ __forceinline__ void norm_mod_mid_phase(const bf16_t* xmid, const float* gain, const float* modl, int ks, bf16_t* XN, int blk, int NGW, int skip) {
    const int tid = fresh_tid(), lane = tid & 63, gw = blk * 8 + __builtin_amdgcn_readfirstlane(tid >> 6);
    const int nrows = skip ? NB * SEQ : MROWS;
    for (int rowb = gw; rowb < nrows; rowb += 4 * NGW) {
        u32x4 v[4][2]; float ss[4];
#pragma unroll
        for (int q = 0; q < 4; ++q) { const int rr = rowb + q * NGW; const int row = skip ? (rr >> 11) * TOK + CTXL + (rr & 2047) : rr;
            const bf16_t* src = xmid + (size_t)row * D + 8 * lane; v[q][0] = *(const u32x4*)src; v[q][1] = *(const u32x4*)(src + 512); }
#pragma unroll
        for (int q = 0; q < 4; ++q) { float a = 0.f;
#pragma unroll
            for (int j = 0; j < 2; ++j) { float f[8]; unpack8(v[q][j], f);
#pragma unroll
                for (int e = 0; e < 8; ++e) a += f[e] * f[e]; }
            ss[q] = a; }
#pragma unroll
        for (int o = 1; o < 64; o <<= 1) {
#pragma unroll
            for (int q = 0; q < 4; ++q) ss[q] += __shfl_xor(ss[q], o); }
#pragma unroll
        for (int q = 0; q < 4; ++q) { const int rr = rowb + q * NGW; const int row = skip ? (rr >> 11) * TOK + CTXL + (rr & 2047) : rr; const int b = row / TOK, pos = row - b * TOK;
            const float* sh = modl + (size_t)(pos < CTXL ? 32 : b) * 6144 + ks * 1024; const float* sc = sh + 1024;
            const float rstd = rsqrtf(ss[q] * (1.0f / D) + EPS);
#pragma unroll
            for (int j = 0; j < 2; ++j) { const int col = 8 * lane + 512 * j; float f[8]; unpack8(v[q][j], f);
                const f32x4 g0 = *(const f32x4*)(gain + col), g1 = *(const f32x4*)(gain + col + 4), s0 = *(const f32x4*)(sc + col), s1 = *(const f32x4*)(sc + col + 4), h0 = *(const f32x4*)(sh + col), h1 = *(const f32x4*)(sh + col + 4);
                f32x4 y0, y1;
#pragma unroll
                for (int e = 0; e < 4; ++e) { y0[e] = f[e] * rstd * g0[e] * (1.0f + s0[e]) + h0[e]; y1[e] = f[4 + e] * rstd * g1[e] * (1.0f + s1[e]) + h1[e]; }
                *(u32x4*)(XN + (size_t)row * D + col) = pack8(y0, y1); } }
    }
}
__device__ __forceinline__ void final_norm_bf16_phase(const bf16_t* xb, float* out, const float* gain, int blk, int NGW) {
    const int tid = fresh_tid(), lane = tid & 63, gw = blk * 8 + __builtin_amdgcn_readfirstlane(tid >> 6);
    f32x4 g4[2][2];
#pragma unroll
    for (int j = 0; j < 2; ++j) { g4[j][0] = *(const f32x4*)(gain + 8 * lane + 512 * j); g4[j][1] = *(const f32x4*)(gain + 8 * lane + 512 * j + 4); }
    for (int rowb = gw; rowb < NB * SEQ; rowb += 4 * NGW) {
        u32x4 v[4][2]; float ss[4];
#pragma unroll
        for (int q = 0; q < 4; ++q) { const int rr = rowb + q * NGW; const int row = (rr >> 11) * TOK + CTXL + (rr & 2047);
            const bf16_t* src = xb + (size_t)row * D + 8 * lane; v[q][0] = *(const u32x4*)src; v[q][1] = *(const u32x4*)(src + 512); }
#pragma unroll
        for (int q = 0; q < 4; ++q) { float a = 0.f;
#pragma unroll
            for (int j = 0; j < 2; ++j) { float f[8]; unpack8(v[q][j], f);
#pragma unroll
                for (int e = 0; e < 8; ++e) a += f[e] * f[e]; }
            ss[q] = a; }
#pragma unroll
        for (int o = 1; o < 64; o <<= 1) {
#pragma unroll
            for (int q = 0; q < 4; ++q) ss[q] += __shfl_xor(ss[q], o); }
#pragma unroll
        for (int q = 0; q < 4; ++q) { const int rr = rowb + q * NGW; const float rstd = rsqrtf(ss[q] * (1.0f / D) + EPS);
#pragma unroll
            for (int j = 0; j < 2; ++j) { const int col = 8 * lane + 512 * j; float f[8]; unpack8(v[q][j], f);
                f32x4 y0, y1;
#pragma unroll
                for (int e = 0; e < 4; ++e) { y0[e] = f[e] * rstd * g4[j][0][e]; y1[e] = f[4 + e] * rstd * g4[j][1][e]; }
                *(f32x4*)(out + (size_t)rr * D + col) = y0; *(f32x4*)(out + (size_t)rr * D + col + 4) = y1; } }
    }
}
__device__ __forceinline__ void final_norm_phase(float* xl, const float* gain, int blk, int NGW) {
    const int tid = fresh_tid(), lane = tid & 63, gw = blk * 8 + __builtin_amdgcn_readfirstlane(tid >> 6);
    f32x4 g4[4];
#pragma unroll
    for (int j = 0; j < 4; ++j) g4[j] = *(const f32x4*)(gain + 4 * (lane + 64 * j));
    for (int rowb = gw; rowb < NB * SEQ; rowb += 4 * NGW) {
        f32x4 v[4][4]; float ss[4];
#pragma unroll
        for (int q = 0; q < 4; ++q) { const float* p = xl + (size_t)(rowb + q * NGW) * D;
#pragma unroll
            for (int j = 0; j < 4; ++j) v[q][j] = ((const f32x4*)p)[lane + 64 * j]; }
#pragma unroll
        for (int q = 0; q < 4; ++q) { float a = 0.f;
#pragma unroll
            for (int j = 0; j < 4; ++j) a += v[q][j][0] * v[q][j][0] + v[q][j][1] * v[q][j][1] + v[q][j][2] * v[q][j][2] + v[q][j][3] * v[q][j][3];
            ss[q] = a; }
#pragma unroll
        for (int o = 1; o < 64; o <<= 1) {
#pragma unroll
            for (int q = 0; q < 4; ++q) ss[q] += __shfl_xor(ss[q], o); }
#pragma unroll
        for (int q = 0; q < 4; ++q) { float* p = xl + (size_t)(rowb + q * NGW) * D; const float rstd = rsqrtf(ss[q] * (1.0f / D) + EPS);
#pragma unroll
            for (int j = 0; j < 4; ++j) ((f32x4*)p)[lane + 64 * j] = v[q][j] * rstd * g4[j]; }
    }
}

struct MixP { const bf16_t* PM; bf16_t* ST; float* DEC; bf16_t* Y; const float* rope; const float* ret_ld; const float* ret_gn; const float* gw; const float* gb; const float* gnorm; };

__device__ __forceinline__ bf16x8 ldsfrag(const LAS bf16_t* p) { return *(const LAS bf16x8*)p; }

__device__ __forceinline__ float dpp_add_(float v, const int ctrl_dummy) { return v; }
#define DPP_STEP(v, ctrl, rmask) v += __builtin_bit_cast(float, __builtin_amdgcn_update_dpp(0, __builtin_bit_cast(int, v), ctrl, rmask, 0xf, false))
__device__ __forceinline__ float wave_incl_scan(float v) {
    DPP_STEP(v, 0x111, 0xf); DPP_STEP(v, 0x112, 0xf); DPP_STEP(v, 0x114, 0xf); DPP_STEP(v, 0x118, 0xf);
    DPP_STEP(v, 0x142, 0xa); DPP_STEP(v, 0x143, 0xc);
    return v;
}
template <int MX> __device__ __forceinline__ void gate_scan(const MixP& P, int h, int d, int kap0, const float (&z)[16], int lane, float (&E)[8], float (&tot)[8]) {
    if constexpr (MX == 0) {
        const float lg = P.ret_ld[d * 4 + h]; const float Ev = lg * (float)(d == 0 ? 63 - lane : lane), tv = 64.0f * lg;
#pragma unroll
        for (int e = 0; e < 8; ++e) { E[e] = Ev; tot[e] = tv; }
    } else {
        const float* w = P.gw + (size_t)d * 16 * 192 + h * 48 + kap0; const float* bb = P.gb + d * 192 + h * 48 + kap0;
#pragma unroll
        for (int e = 0; e < 8; ++e) { float pre = bb[e];
#pragma unroll
            for (int r = 0; r < 16; ++r) pre += z[r] * w[r * 192 + e];
            const float sp = fmaxf(-pre, 0.f) + __logf(1.0f + __expf(-fabsf(pre)));
            const float g = -sp * (1.0f / 16.0f);
            const float p = wave_incl_scan(g);
            tot[e] = __builtin_bit_cast(float, __builtin_amdgcn_readlane(__builtin_bit_cast(int, p), 63));
            E[e] = (d == 0) ? tot[e] - p : p - g; }
    }
}
__device__ __forceinline__ void load_z(const MixP& P, int mx, size_t rowtok, int d, float (&z)[16]) {
    if (mx == 1) { const u32x4 a = *(const u32x4*)(P.PM + pm_off(rowtok, 2304 + 16 * d)), b = *(const u32x4*)(P.PM + pm_off(rowtok, 2304 + 16 * d + 8));
        float t0[8], t1[8]; unpack8(a, t0); unpack8(b, t1);
#pragma unroll
        for (int r = 0; r < 8; ++r) { z[r] = t0[r]; z[8 + r] = t1[r]; }
    } else {
#pragma unroll
        for (int r = 0; r < 16; ++r) z[r] = 0.f;
    }
}
__device__ __forceinline__ void rope8(const MixP& P, int tpos, int kap0, float (&v)[8]) {
    const float* t = P.rope + ((size_t)tpos * 24 + (kap0 >> 1)) * 2;
    const f32x4 cs0 = *(const f32x4*)t, cs1 = *(const f32x4*)(t + 4);
    float a, b;
    a = v[0]; b = v[1]; v[0] = a * cs0[0] - b * cs0[1]; v[1] = a * cs0[1] + b * cs0[0];
    a = v[2]; b = v[3]; v[2] = a * cs0[2] - b * cs0[3]; v[3] = a * cs0[3] + b * cs0[2];
    a = v[4]; b = v[5]; v[4] = a * cs1[0] - b * cs1[1]; v[5] = a * cs1[1] + b * cs1[0];
    a = v[6]; b = v[7]; v[6] = a * cs1[2] - b * cs1[3]; v[7] = a * cs1[3] + b * cs1[2];
}
struct ItemId { int mx, hp, b, c; size_t row0; };
__device__ __forceinline__ ItemId item_decode(int it) { ItemId I; I.mx = it / 2304; const int r = it - I.mx * 2304, bc = r >> 1; I.hp = r & 1; I.b = bc / 36; I.c = bc - 36 * I.b; I.row0 = (size_t)I.b * TOK + I.c * 64; return I; }
__device__ __forceinline__ int next_item(int it, int G, int skip) {
    while (it < 4608 && skip) { const int r = it % 2304, c = (r >> 1) % 36; if (c >= 4) break; it += G; }
    return it;
}
__device__ __forceinline__ void rope8r(const f32x4 cs0, const f32x4 cs1, float (&v)[8]) {
    float a, b;
    a = v[0]; b = v[1]; v[0] = a * cs0[0] - b * cs0[1]; v[1] = a * cs0[1] + b * cs0[0];
    a = v[2]; b = v[3]; v[2] = a * cs0[2] - b * cs0[3]; v[3] = a * cs0[3] + b * cs0[2];
    a = v[4]; b = v[5]; v[4] = a * cs1[0] - b * cs1[1]; v[5] = a * cs1[1] + b * cs1[0];
    a = v[6]; b = v[7]; v[6] = a * cs1[2] - b * cs1[3]; v[7] = a * cs1[3] + b * cs1[2];
}
__device__ __forceinline__ void vT_write(const u32x4 (&v)[3], LAS bf16_t* vT, int wid, int lane) {
#pragma unroll
    for (int pass = 0; pass < 3; ++pass) { const int grp = pass * 8 + wid, h2 = grp / 12, dv0 = (grp - 12 * h2) * 8; const u32x4 w = v[pass];
        LAS bf16_t* o = vT + (h2 * 96 + dv0) * 72 + lane;
        o[0 * 72] = (bf16_t)(w.x & 0xffff); o[1 * 72] = (bf16_t)(w.x >> 16); o[2 * 72] = (bf16_t)(w.y & 0xffff); o[3 * 72] = (bf16_t)(w.y >> 16);
        o[4 * 72] = (bf16_t)(w.z & 0xffff); o[5 * 72] = (bf16_t)(w.z >> 16); o[6 * 72] = (bf16_t)(w.w & 0xffff); o[7 * 72] = (bf16_t)(w.w >> 16); }
}
struct StRegs { u32x4 v[6]; u32x4 z[2]; u32x4 k[6]; };
__device__ __forceinline__ void state_load(const MixP& P, int mx, int b, int c, StRegs& R, int wid, int lane) {
    const int voff = mx ? 1536 : 384, koff = mx ? 1344 : 192;
    const size_t rowt = (size_t)b * TOK + c * 64 + lane;
#pragma unroll
    for (int pass = 0; pass < 6; ++pass) { const int grp = pass * 8 + wid; R.v[pass] = *(const u32x4*)(P.PM + pm_off(rowt, voff + grp * 8)); }
    const int h = wid >> 1, d = wid & 1;
    if (mx == 1) { R.z[0] = *(const u32x4*)(P.PM + pm_off(rowt, 2304 + 16 * d)); R.z[1] = *(const u32x4*)(P.PM + pm_off(rowt, 2304 + 16 * d + 8)); }
    else { R.z[0] = (u32x4){0u, 0u, 0u, 0u}; R.z[1] = (u32x4){0u, 0u, 0u, 0u}; }
#pragma unroll
    for (int grp = 0; grp < 6; ++grp) R.k[grp] = *(const u32x4*)(P.PM + pm_off(rowt, koff + h * 48 + 8 * grp));
}
template <int MX> __device__ __forceinline__ void state_write(const MixP& P, int b, int c, const StRegs& R, LAS bf16_t* vT, LAS bf16_t* KHT, bf16_t* EX, int wid, int lane) {
    const int h = wid >> 1, d = wid & 1;
    const size_t rowt = (size_t)b * TOK + c * 64 + lane;
#pragma unroll
    for (int pass = 0; pass < 6; ++pass) { const int grp = pass * 8 + wid; const u32x4 w = R.v[pass];
        LAS bf16_t* o = vT + (grp * 8) * 72 + lane;
        o[0 * 72] = (bf16_t)(w.x & 0xffff); o[1 * 72] = (bf16_t)(w.x >> 16); o[2 * 72] = (bf16_t)(w.y & 0xffff); o[3 * 72] = (bf16_t)(w.y >> 16);
        o[4 * 72] = (bf16_t)(w.z & 0xffff); o[5 * 72] = (bf16_t)(w.z >> 16); o[6 * 72] = (bf16_t)(w.w & 0xffff); o[7 * 72] = (bf16_t)(w.w >> 16); }
    float z[16];
    { float t0[8], t1[8]; unpack8(R.z[0], t0); unpack8(R.z[1], t1);
#pragma unroll
      for (int r = 0; r < 8; ++r) { z[r] = t0[r]; z[8 + r] = t1[r]; } }
    f32x4 rp[6][2];
#pragma unroll
    for (int grp = 0; grp < 6; ++grp) {
        if (MX == 0 && c >= 4) { const float* t = P.rope + ((size_t)((c - 4) * 64 + lane) * 24 + 4 * grp) * 2; rp[grp][0] = *(const f32x4*)t; rp[grp][1] = *(const f32x4*)(t + 4); }
        else { rp[grp][0] = (f32x4){1.f, 0.f, 1.f, 0.f}; rp[grp][1] = (f32x4){1.f, 0.f, 1.f, 0.f}; } }
#pragma unroll
    for (int grp = 0; grp < 6; ++grp) { const int kap0 = 8 * grp;
        float E[8], tot[8]; gate_scan<MX>(P, h, d, kap0, z, lane, E, tot);
        float kk[8]; unpack8(R.k[grp], kk);
        if (MX == 0) rope8r(rp[grp][0], rp[grp][1], kk);
        float ex[8];
#pragma unroll
        for (int e = 0; e < 8; ++e) ex[e] = __expf(E[e]);
        if constexpr (MX == 1) { u32x4 w; w.x = pk2(ex[0], ex[1]); w.y = pk2(ex[2], ex[3]); w.z = pk2(ex[4], ex[5]); w.w = pk2(ex[6], ex[7]);
            *(u32x4*)(EX + ex_off(rowt, d * 192 + h * 48 + kap0)) = w; }
        LAS bf16_t* o = KHT + ((h * 2 + d) * 48 + kap0) * 72 + lane;
#pragma unroll
        for (int e = 0; e < 8; ++e) o[e * 72] = f2bf(kk[e] * ex[e]);
        if (lane == 0) { float* dp = P.DEC + ((((size_t)(MX * 32 + b) * 36 + c) * 4 + h) * 2 + d) * 48 + kap0;
#pragma unroll
            for (int e = 0; e < 8; ++e) dp[e] = __expf(tot[e]); } }
}
__device__ __forceinline__ void mix_state_phase(const MixP& P, bf16_t* EX, LAS unsigned char* lds, int blk, int G) {
    int tid = threadIdx.x; asm volatile("" : "+v"(tid));
    const int wid = __builtin_amdgcn_readfirstlane(tid >> 6), lane = tid & 63;
    LAS bf16_t* vT = (LAS bf16_t*)lds;
    LAS bf16_t* KHT = (LAS bf16_t*)(lds + 4 * 96 * 72 * 2);
    int it = blk; StRegs R;
    int mx = it / 1152, bc = it - mx * 1152, b = bc / 36, c = bc - 36 * b;
    if (it < 2304) state_load(P, mx, b, c, R, wid, lane);
    while (it < 2304) {
        if (mx == 0) state_write<0>(P, b, c, R, vT, KHT, EX, wid, lane); else state_write<1>(P, b, c, R, vT, KHT, EX, wid, lane);
        __syncthreads();
        const int cmx = mx, cb = b, cc = c;
        const int nit = it + G;
        if (nit < 2304) { mx = nit / 1152; bc = nit - mx * 1152; b = bc / 36; c = bc - 36 * b; state_load(P, mx, b, c, R, wid, lane); }
        { const int h = wid >> 1, d = wid & 1, fr = lane & 15, fq = lane >> 4;
          f32x4 acc[6][3];
#pragma unroll
          for (int i = 0; i < 6; ++i)
#pragma unroll
              for (int j = 0; j < 3; ++j) acc[i][j] = (f32x4){0.f, 0.f, 0.f, 0.f};
#pragma unroll
          for (int ks = 0; ks < 2; ++ks) { bf16x8 bq[3];
#pragma unroll
              for (int j = 0; j < 3; ++j) bq[j] = ldsfrag(KHT + ((h * 2 + d) * 48 + 16 * j + fr) * 72 + 32 * ks + 8 * fq);
#pragma unroll
              for (int i = 0; i < 6; ++i) { const bf16x8 a = ldsfrag(vT + (h * 96 + 16 * i + fr) * 72 + 32 * ks + 8 * fq);
#pragma unroll
                  for (int j = 0; j < 3; ++j) acc[i][j] = __builtin_amdgcn_mfma_f32_16x16x32_bf16(bq[j], a, acc[i][j], 0, 0, 0); } }
          bf16_t* sp = P.ST + (((((size_t)(cmx * 32 + cb) * 4 + h) * 2 + d) * 36 + cc) * 4608);
#pragma unroll
          for (int i = 0; i < 6; ++i)
#pragma unroll
              for (int j = 0; j < 3; ++j) { u32x2 w; w.x = pk2(acc[i][j][0], acc[i][j][1]); w.y = pk2(acc[i][j][2], acc[i][j][3]);
                  *(u32x2*)(sp + (16 * i + fr) * 48 + 16 * j + 4 * fq) = w; } }
        __syncthreads();
        it = nit;
    }
}
__device__ __forceinline__ int chunk_order36(int d, int ci) { return d == 0 ? ci : (ci < 4 ? 3 - ci : 39 - ci); }
__device__ __forceinline__ int chunk_order72(int d, int ci) { return d == 0 ? ci : (ci < 8 ? 7 - ci : 79 - ci); }
__device__ __forceinline__ void mix_scan_phase(const MixP& P, int blk, int G) {
    const int tid = fresh_tid();
    for (int w = blk * 4 + (tid >> 7); w < 512 * 9; w += 4 * G) {
        const int seq = w / 9, e = ((w - seq * 9) * 128 + (tid & 127)) * 4, kap = e % 48;
        const int d = seq & 1, h = (seq >> 1) & 3, mb = seq >> 3;
        bf16_t* base = P.ST + (size_t)seq * 36 * 4608 + e;
        const float* dbase = P.DEC + (size_t)mb * 36 * 384 + (h * 2 + d) * 48 + kap;
        f32x4 S = {0.f, 0.f, 0.f, 0.f};
#pragma unroll
        for (int half = 0; half < 2; ++half) {
            u32x2 dS[18]; f32x4 dc[18];
#pragma unroll
            for (int j = 0; j < 18; ++j) { const int c = chunk_order36(d, half * 18 + j); dS[j] = *(const u32x2*)(base + (size_t)c * 4608); dc[j] = *(const f32x4*)(dbase + c * 384); }
#pragma unroll
            for (int j = 0; j < 18; ++j) { const f32x4 p = dc[j] * S; S[0] = p[0] + bflo(dS[j].x); S[1] = p[1] + bfhi(dS[j].x); S[2] = p[2] + bflo(dS[j].y); S[3] = p[3] + bfhi(dS[j].y);
                dS[j].x = pk2(p[0], p[1]); dS[j].y = pk2(p[2], p[3]); }
#pragma unroll
            for (int j = 0; j < 18; ++j) { const int c = chunk_order36(d, half * 18 + j); *(u32x2*)(base + (size_t)c * 4608) = dS[j]; }
        }
    }
}
struct OutRegs { u32x4 v[3]; u32x4 k[3], q[3], ex[3]; };
__device__ __forceinline__ void out_load(const MixP& P, const bf16_t* EX, const ItemId& I, OutRegs& R, int tid, int wid, int lane) {
    const int voff = I.mx ? 1536 : 384, qoff = I.mx ? 1152 : 0, koff = I.mx ? 1344 : 192;
    const size_t rowt = I.row0 + lane;
#pragma unroll
    for (int pass = 0; pass < 3; ++pass) { const int grp = pass * 8 + wid, h2 = grp / 12, dv0 = (grp - 12 * h2) * 8; R.v[pass] = *(const u32x4*)(P.PM + pm_off(rowt, voff + (2 * I.hp + h2) * 96 + dv0)); }
    const int h2 = wid >> 2, d = (wid >> 1) & 1, kh = wid & 1, h = 2 * I.hp + h2;
#pragma unroll
    for (int grp = 0; grp < 3; ++grp) { const int kap0 = 24 * kh + 8 * grp;
        R.k[grp] = *(const u32x4*)(P.PM + pm_off(rowt, koff + h * 48 + kap0)); R.q[grp] = *(const u32x4*)(P.PM + pm_off(rowt, qoff + h * 48 + kap0));
        if (I.mx == 1) R.ex[grp] = *(const u32x4*)(EX + ex_off(rowt, d * 192 + h * 48 + kap0)); else R.ex[grp] = (u32x4){0u, 0u, 0u, 0u}; }
}
template <int MX> __device__ __forceinline__ void out_write(const MixP& P, const ItemId& I, const OutRegs& R, LAS bf16_t* vT, LAS bf16_t* QC, LAS bf16_t* KH, LAS bf16_t* SpT, int tid, int wid, int lane) {
    const int h2 = wid >> 2, d = (wid >> 1) & 1, kh = wid & 1, h = 2 * I.hp + h2;
    u32x4 sp[5]; f32x4 rp[3][2];
#pragma unroll
    for (int i = 0; i < 5; ++i) { const int idx = tid + 512 * i;
        if (idx < 2304) { const int q4 = idx / 576, off = idx - q4 * 576;
            sp[i] = *(const u32x4*)(P.ST + (((((size_t)(I.mx * 32 + I.b) * 4 + (2 * I.hp + (q4 >> 1))) * 2 + (q4 & 1)) * 36 + I.c) * 4608) + off * 8); }
        else sp[i] = (u32x4){0u, 0u, 0u, 0u}; }
#pragma unroll
    for (int grp = 0; grp < 3; ++grp) { const int kap0 = 24 * kh + 8 * grp;
        if (MX == 0 && I.c >= 4) { const float* t = P.rope + ((size_t)((I.c - 4) * 64 + lane) * 24 + (kap0 >> 1)) * 2; rp[grp][0] = *(const f32x4*)t; rp[grp][1] = *(const f32x4*)(t + 4); }
        else { rp[grp][0] = (f32x4){1.f, 0.f, 1.f, 0.f}; rp[grp][1] = (f32x4){1.f, 0.f, 1.f, 0.f}; } }
    vT_write(R.v, vT, wid, lane);
    float rex = 1.f, rexi = 1.f;
    if constexpr (MX == 0) { const float Ev = P.ret_ld[d * 4 + h] * (float)(d == 0 ? 63 - lane : lane); rex = __expf(Ev); rexi = __expf(-Ev); }
#pragma unroll
    for (int grp = 0; grp < 3; ++grp) { const int kap0 = 24 * kh + 8 * grp;
        float kk[8], qq[8]; unpack8(R.k[grp], kk); unpack8(R.q[grp], qq);
        rope8r(rp[grp][0], rp[grp][1], kk); rope8r(rp[grp][0], rp[grp][1], qq);
        if constexpr (MX == 0) {
#pragma unroll
            for (int e = 0; e < 8; ++e) { kk[e] *= rex; qq[e] *= rexi; }
        } else { float ex[8]; unpack8(R.ex[grp], ex);
#pragma unroll
            for (int e = 0; e < 8; ++e) { kk[e] *= ex[e]; qq[e] *= __builtin_amdgcn_rcpf(ex[e]); } }
        u32x4 wk, wq; wk.x = pk2(kk[0], kk[1]); wk.y = pk2(kk[2], kk[3]); wk.z = pk2(kk[4], kk[5]); wk.w = pk2(kk[6], kk[7]);
        wq.x = pk2(qq[0], qq[1]); wq.y = pk2(qq[2], qq[3]); wq.z = pk2(qq[4], qq[5]); wq.w = pk2(qq[6], qq[7]);
        *(LAS u32x4*)(KH + ((h2 * 2 + d) * 64 + lane) * 48 + kap0) = wk;
        *(LAS u32x4*)(QC + ((h2 * 2 + d) * 64 + lane) * 48 + kap0) = wq; }
#pragma unroll
    for (int i = 0; i < 5; ++i) { const int idx = tid + 512 * i; if (idx < 2304) *(LAS u32x4*)(SpT + idx * 8) = sp[i]; }
}
__device__ __forceinline__ void mix_out_phase(const MixP& P, const bf16_t* EX, LAS unsigned char* lds, int blk, int G, int skip) {
    int tid = threadIdx.x; asm volatile("" : "+v"(tid));
    const int wid = __builtin_amdgcn_readfirstlane(tid >> 6), lane = tid & 63;
    LAS bf16_t* vT = (LAS bf16_t*)lds;
    LAS bf16_t* QC = (LAS bf16_t*)(lds + 27648);
    LAS bf16_t* KH = (LAS bf16_t*)(lds + 27648 + 24576);
    LAS bf16_t* SpT = (LAS bf16_t*)(lds + 27648 + 2 * 24576);
    LAS bf16_t* ATT = (LAS bf16_t*)(lds + 27648 + 2 * 24576 + 36864);
    LAS float* GAINS = (LAS float*)(lds + 27648 + 2 * 24576 + 36864 + 18432);
    for (int idx = tid; idx < 768; idx += 512) GAINS[idx] = idx < 384 ? P.ret_gn[idx] : P.gnorm[idx - 384];
    int it = next_item(blk, G, skip); OutRegs R; ItemId I = item_decode(it < 4608 ? it : 0);
    if (it < 4608) out_load(P, EX, I, R, tid, wid, lane);
    while (it < 4608) {
        if (I.mx == 0) out_write<0>(P, I, R, vT, QC, KH, SpT, tid, wid, lane); else out_write<1>(P, I, R, vT, QC, KH, SpT, tid, wid, lane);
        __syncthreads();
        const int mx = I.mx, hp = I.hp; const size_t row0 = I.row0;
        const int nit = next_item(it + G, G, skip);
        if (nit < 4608) { I = item_decode(nit); out_load(P, EX, I, R, tid, wid, lane); }
        if (wid < 4) {
            const int h2 = wid >> 1, ih = wid & 1, i0 = 32 * ih, h = 2 * hp + h2, l31 = lane & 31, lh = lane >> 5;
            LAS bf16_t* att = ATT + wid * 32 * 72;
#pragma unroll
            for (int jt = 0; jt < 2; ++jt) {
                f32x16 af, ab;
#pragma unroll
                for (int e = 0; e < 16; ++e) { af[e] = 0.f; ab[e] = 0.f; }
#pragma unroll
                for (int ks = 0; ks < 3; ++ks) {
                    const bf16x8 a0 = ldsfrag(KH + ((h2 * 2 + 0) * 64 + 32 * jt + l31) * 48 + 16 * ks + 8 * lh), q0 = ldsfrag(QC + ((h2 * 2 + 0) * 64 + i0 + l31) * 48 + 16 * ks + 8 * lh);
                    const bf16x8 a1 = ldsfrag(KH + ((h2 * 2 + 1) * 64 + 32 * jt + l31) * 48 + 16 * ks + 8 * lh), q1 = ldsfrag(QC + ((h2 * 2 + 1) * 64 + i0 + l31) * 48 + 16 * ks + 8 * lh);
                    af = __builtin_amdgcn_mfma_f32_32x32x16_bf16(a0, q0, af, 0, 0, 0);
                    ab = __builtin_amdgcn_mfma_f32_32x32x16_bf16(a1, q1, ab, 0, 0, 0); }
                const int ig = i0 + l31;
#pragma unroll
                for (int q = 0; q < 4; ++q) { float v[4];
#pragma unroll
                    for (int e = 0; e < 4; ++e) { const int jg = 32 * jt + 8 * q + 4 * lh + e; v[e] = (jg <= ig ? af[4 * q + e] : 0.f) + (jg >= ig ? ab[4 * q + e] : 0.f); }
                    u32x2 w; w.x = pk2(v[0], v[1]); w.y = pk2(v[2], v[3]);
                    *(LAS u32x2*)(att + l31 * 72 + 32 * jt + 8 * q + 4 * lh) = w; }
            }
            LDS_WAIT();
            f32x16 o[3];
#pragma unroll
            for (int mt = 0; mt < 3; ++mt) {
#pragma unroll
                for (int e = 0; e < 16; ++e) o[mt][e] = 0.f;
#pragma unroll
                for (int ks = 0; ks < 4; ++ks) o[mt] = __builtin_amdgcn_mfma_f32_32x32x16_bf16(ldsfrag(vT + (h2 * 96 + 32 * mt + l31) * 72 + 16 * ks + 8 * lh), ldsfrag(att + l31 * 72 + 16 * ks + 8 * lh), o[mt], 0, 0, 0);
#pragma unroll
                for (int d = 0; d < 2; ++d)
#pragma unroll
                    for (int ks = 0; ks < 3; ++ks) o[mt] = __builtin_amdgcn_mfma_f32_32x32x16_bf16(ldsfrag(SpT + ((h2 * 2 + d) * 96 + 32 * mt + l31) * 48 + 16 * ks + 8 * lh), ldsfrag(QC + ((h2 * 2 + d) * 64 + i0 + l31) * 48 + 16 * ks + 8 * lh), o[mt], 0, 0, 0);
            }
            float s = 0.f;
#pragma unroll
            for (int mt = 0; mt < 3; ++mt)
#pragma unroll
                for (int e = 0; e < 16; ++e) s += o[mt][e];
            s += __shfl_xor(s, 32);
            const float mu = (mx == 0) ? s * (1.0f / 96.0f) : 0.f;
            float s2 = 0.f;
#pragma unroll
            for (int mt = 0; mt < 3; ++mt)
#pragma unroll
                for (int e = 0; e < 16; ++e) { const float dlt = o[mt][e] - mu; s2 += dlt * dlt; }
            s2 += __shfl_xor(s2, 32);
            const float rstd = rsqrtf(s2 * (1.0f / 96.0f) + EPS);
            const LAS float* gain = GAINS + mx * 384 + h * 96;
            const size_t rowt = row0 + i0 + l31;
            const bf16_t* gp = P.PM + pm_off(rowt, (mx ? 1920 : 768) + h * 96) + 4 * lh;
            bf16_t* yp = P.Y + rowt * 1024 + 256 + mx * 384 + h * 96;
            u32x2 gring[2]; gring[0] = *(const u32x2*)(gp);
#pragma unroll
            for (int mt = 0; mt < 3; ++mt)
#pragma unroll
                for (int q = 0; q < 4; ++q) { const int dv = 32 * mt + 8 * q + 4 * lh, t = 4 * mt + q;
                    if (t + 1 < 12) gring[(t + 1) & 1] = *(const u32x2*)(gp + 512 * (t + 1));
                    const u32x2 gv = gring[t & 1]; const f32x4 g4 = *(const LAS f32x4*)(gain + dv);
                    const float y0 = (o[mt][4 * q + 0] - mu) * rstd * g4[0] * siluf_(bflo(gv.x)), y1 = (o[mt][4 * q + 1] - mu) * rstd * g4[1] * siluf_(bfhi(gv.x));
                    const float y2 = (o[mt][4 * q + 2] - mu) * rstd * g4[2] * siluf_(bflo(gv.y)), y3 = (o[mt][4 * q + 3] - mu) * rstd * g4[3] * siluf_(bfhi(gv.y));
                    u32x2 w; w.x = pk2(y0, y1); w.y = pk2(y2, y3);
                    *(u32x2*)(yp + dv) = w; }
        }
        __syncthreads();
        it = nit;
    }
}

__device__ __forceinline__ void s5_scan_phase(const float* AP, const float* SS, bf16_t* UH, int blk, int G) {
    const int tid = fresh_tid();
    if (tid < 256) {
        for (int idx = blk * 256 + tid; idx < 65536; idx += G * 256) {
            const int p = idx & 63, d = (idx >> 6) & 1, g = (idx >> 7) & 15, b = idx >> 11;
            const float* ap = AP + ((((size_t)g * 2 + d) * 64 + p) * 33 + 32) * 2;
            const float ar = ap[0], ai = ap[1];
            float hr = 0.f, hi = 0.f;
            for (int c0 = 0; c0 < 72; c0 += 24) {
                float sr[24], si[24];
#pragma unroll
                for (int j = 0; j < 24; ++j) { const int c = chunk_order72(d, c0 + j); const float* sp = SS + ((size_t)g * 2304 + b * 72 + c) * 256 + d * 128 + p; sr[j] = sp[0]; si[j] = sp[64]; }
#pragma unroll
                for (int j = 0; j < 24; ++j) { const int c = chunk_order72(d, c0 + j); bf16_t* hp = UH + ((size_t)g * 2304 + b * 72 + c) * 768 + 512 + d * 128 + p;
                    hp[0] = f2bf(hr); hp[64] = f2bf(hi);
                    const float nr = ar * hr - ai * hi + sr[j], ni = ar * hi + ai * hr + si[j]; hr = nr; hi = ni; }
            }
        }
    }
}

#ifndef DBG_STOP
#define DBG_STOP 0
#endif
__device__ __forceinline__ void dbg_digest_bf16(float* out, const bf16_t* buf, size_t n, int ld, int c0, int c1, int blk, int G, bool first) {
    const size_t NOUT = (size_t)NB * SEQ * D;
    for (size_t i = (size_t)blk * 512 + fresh_tid(); i < NOUT; i += (size_t)G * 512) { float s = first ? 0.f : out[i];
        for (size_t j = i; j < n; j += NOUT) { const int c = (int)(j % ld); if (c >= c0 && c < c1) s += bf2f(buf[j]); }
        out[i] = s; }
}
__device__ __forceinline__ void dbg_digest_f32(float* out, const float* buf, size_t n, int blk, int G, bool first) {
    const size_t NOUT = (size_t)NB * SEQ * D;
    for (size_t i = (size_t)blk * 512 + fresh_tid(); i < NOUT; i += (size_t)G * 512) { float s = first ? 0.f : out[i];
        for (size_t j = i; j < n; j += NOUT) s += buf[j];
        out[i] = s; }
}

#define KAS __attribute__((address_space(4)))
__device__ __forceinline__ const KAS unsigned char* karg_() { const KAS unsigned char* ka = (const KAS unsigned char*)__builtin_amdgcn_kernarg_segment_ptr(); asm volatile("" : "+s"(ka)); return ka; }
__device__ __forceinline__ const float* IN_(int k) { return *(const float* const KAS*)(karg_() + 8 * k); }
__device__ __forceinline__ float* OUT_() { return *(float* const KAS*)(karg_() + 248); }
__device__ __forceinline__ unsigned char* WS_() { return *(unsigned char* const KAS*)(karg_() + 256); }
__global__ void __launch_bounds__(512, 2) fwd_megakernel(Params prm) {
    extern __shared__ __attribute__((aligned(16))) unsigned char smem[];
    LAS unsigned char* lds = (LAS unsigned char*)smem;
    cg::grid_group grid = cg::this_grid();
    const int G = gridDim.x, blk = blockIdx.x, NGW = G * 8;
#define ws WS_()
    volatile LAS unsigned* bst = (volatile LAS unsigned*)(lds + LDS_BYTES - 16);
    if (threadIdx.x == 0) { bst[0] = 0u; bst[1] = 0u; }
    __syncthreads();
    (void)xcd_barrier_post((unsigned*)(ws + WS_BAR), bst);
#define XBAR() do { XcdBarrier _xb; _xb.bar = (unsigned*)(WS_() + WS_BAR); _xb.x = xb_xcc_id(); _xb.st = (volatile LAS unsigned*)(lds + LDS_BYTES - 16); xcd_barrier(_xb); } while (0)
#define Wb ((bf16_t*)(WS_() + WS_W))
#define Tb ((float*)(WS_() + WS_T))
#define MOD ((float*)(WS_() + WS_MOD))
#define ROPE ((float*)(WS_() + WS_ROPE))
#define CTXR ((float*)(WS_() + WS_CTX))
#define XN ((bf16_t*)(WS_() + WS_XN))
#define ST ((bf16_t*)(WS_() + WS_ST))
#define DEC ((float*)(WS_() + WS_DEC))
#define PM ((bf16_t*)(WS_() + WS_PM))
#define UH ((bf16_t*)(WS_() + WS_UH))
#define YB ((bf16_t*)(WS_() + WS_YB))
#define Hb ((bf16_t*)(WS_() + WS_H))
#define Y ((bf16_t*)(WS_() + WS_Y))
#define M1 ((bf16_t*)(WS_() + WS_M1))
#define Y5 ((bf16_t*)(WS_() + WS_Y5))
#define SS ((float*)(WS_() + WS_SS))
#define OUT OUT_()

    {
        const int tid = fresh_tid(), wid = __builtin_amdgcn_readfirstlane(tid >> 6), lane = tid & 63, gw = blk * 8 + wid;
        for (int idx = blk * 512 + tid; idx < 2048 * 24; idx += G * 512) { const int t = idx / 24, i = idx - 24 * t; const int pos = i < 12 ? (t >> 6) : (t & 63);
            const float inv = exp2f(-(float)(i % 12) * (13.287712379549449f / 12.0f)); const float ang = (float)pos * inv;
            ROPE[2 * idx] = cosf(ang); ROPE[2 * idx + 1] = sinf(ang); }
        for (int idx = (G > 192 ? (blk - 192) : blk) * 512 + tid; (G <= 192 || blk >= 192) && idx < 4096; idx += (G > 192 ? (G - 192) : G) * 512) {
            const int p = idx & 63, d = (idx >> 6) & 1, g = (idx >> 7) & 15, l = idx >> 11;
            const float lr = IN_(9)[((size_t)(l * 2 + d) * 16 + g) * 64 + p], li = IN_(10)[((size_t)(l * 2 + d) * 16 + g) * 64 + p];
            const float dt = __expf(IN_(11)[(l * 2 + d) * 16 + g]) ; const float dtp = expf(IN_(11)[(l * 2 + d) * 16 + g]); (void)dt;
            float* ap = Tb + (size_t)l * TL_END + TL_AP + (((size_t)g * 2 + d) * 64 + p) * 33 * 2;
            for (int tau = 0; tau <= 32; ++tau) { const float mag = expf(lr * dtp * (float)tau);
                double ang = (double)li * (double)dtp * (double)tau; ang -= 6.283185307179586 * rint(ang * 0.15915494309189535);
                const float af = (float)ang; ap[2 * tau] = mag * cosf(af); ap[2 * tau + 1] = mag * sinf(af); }
            const float th = li * dtp, em1 = expm1f(lr * dtp), sh = sinf(0.5f * th);
            const float am1r = em1 * cosf(th) - 2.0f * sh * sh, aim = (em1 + 1.0f) * sinf(th);
            const float den = lr * lr + li * li;
            const float fr_ = (am1r * lr + aim * li) / den, fi_ = (aim * lr - am1r * li) / den;
            float* bbp = Tb + (size_t)l * TL_END + TL_BB + (((size_t)g * 2 + d) * 64 + p) * 16 * 2;
            const float* br = IN_(12) + (((size_t)l * 16 + g) * 64 + p) * 16; const float* bi = IN_(13) + (((size_t)l * 16 + g) * 64 + p) * 16;
            for (int c = 0; c < 16; ++c) { bbp[2 * c] = fr_ * br[c] - fi_ * bi[c]; bbp[2 * c + 1] = fr_ * bi[c] + fi_ * br[c]; }
        }
        __syncthreads();
        if (blk < 192) {
            constexpr int SCS = 1028;
            LAS float* sc = (LAS float*)lds;
            for (int idx = tid; idx < 33 * 256; idx += 512) { const int mv = idx >> 8, k = (idx & 255) * 4; const f32x4 v = mv < 32 ? *(const f32x4*)(IN_(1) + mv * 1024 + k) : *(const f32x4*)(IN_(3) + k);
                *(LAS f32x4*)(sc + mv * SCS + k) = (f32x4){siluf_(v[0]), siluf_(v[1]), siluf_(v[2]), siluf_(v[3])}; }
            __syncthreads();
            const int l = blk / 96, n0 = (blk % 96) * 64, l31 = lane & 31, lh = lane >> 5;
            const float* wm = IN_(4) + (size_t)l * 1024 * 6144 + n0;
            f32x16 acc0, acc1; float accx = 0.f;
#pragma unroll
            for (int e = 0; e < 16; ++e) { acc0[e] = 0.f; acc1[e] = 0.f; }
#pragma unroll 8
            for (int k = wid * 128; k < wid * 128 + 128; k += 2) {
                const float a = sc[l31 * SCS + k + lh];
                const float b0 = wm[(size_t)(k + lh) * 6144 + l31], b1 = wm[(size_t)(k + lh) * 6144 + 32 + l31];
                acc0 = __builtin_amdgcn_mfma_f32_32x32x2f32(a, b0, acc0, 0, 0, 0);
                acc1 = __builtin_amdgcn_mfma_f32_32x32x2f32(a, b1, acc1, 0, 0, 0);
                accx += sc[32 * SCS + k] * wm[(size_t)k * 6144 + lane] + sc[32 * SCS + k + 1] * wm[(size_t)(k + 1) * 6144 + lane]; }
            __syncthreads();
            LAS float* red = (LAS float*)lds;
#pragma unroll
            for (int r = 0; r < 16; ++r) { const int mv = (r & 3) + 8 * (r >> 2) + 4 * lh;
                red[(wid * 33 + mv) * 64 + l31] = acc0[r]; red[(wid * 33 + mv) * 64 + 32 + l31] = acc1[r]; }
            red[(wid * 33 + 32) * 64 + lane] = accx;
            __syncthreads();
            for (int idx = tid; idx < 33 * 64; idx += 512) { const int mv = idx >> 6, ln = idx & 63; float s = 0.f;
#pragma unroll
                for (int w = 0; w < 8; ++w) s += red[(w * 33 + mv) * 64 + ln];
                const int nn = (blk % 96) * 64 + ln; MOD[((size_t)l * 33 + mv) * 6144 + nn] = s + IN_(5)[l * 6144 + nn]; }
        }
    }
    GSYNC();
    {
        const int tid = fresh_tid(), wid = __builtin_amdgcn_readfirstlane(tid >> 6), lane = tid & 63, gw = blk * 8 + wid;
        LAS float* scr = (LAS float*)(lds + wid * 8448);
        const float qs = 0.14433756729740643f;
        for (int l = 0; l < 2; ++l) {
            bf16_t* W = Wb + (size_t)l * WL_END;
            const float* w_in = IN_(8) + (size_t)l * 1024 * INDIM;
            xpose_job(w_in, INDIM, 1024, 448, 0, W + WL_MIX, 1024, 0, 1.0f, 0, gw, NGW, scr, lane);
            xpose_job(w_in, INDIM, 1024, 192, 448, W + WL_MIX, 1024, 448, qs, 0, gw, NGW, scr, lane);
            xpose_job(w_in, INDIM, 1024, 768, 640, W + WL_MIX, 1024, 640, 1.0f, 0, gw, NGW, scr, lane);
            xpose_job(w_in, INDIM, 1024, 192, 1408, W + WL_MIX, 1024, 1408, qs, 0, gw, NGW, scr, lane);
            xpose_job(w_in, INDIM, 1024, 992, 1600, W + WL_MIX, 1024, 1600, 1.0f, 0, gw, NGW, scr, lane);
            xpose_job(w_in, INDIM, 1024, 3072, 2592, W + WL_G, 1024, 0, 1.0f, 0, gw, NGW, scr, lane);
            xpose_job(IN_(24) + (size_t)l * 256 * 1024, 1024, 256, 1024, 0, W + WL_BR, 1024, 0, 1.0f, 0, gw, NGW, scr, lane);
            xpose_job(IN_(25) + (size_t)l * 384 * 1024, 1024, 384, 1024, 0, W + WL_BR + 256, 1024, 0, 1.0f, 0, gw, NGW, scr, lane);
            xpose_job(IN_(26) + (size_t)l * 384 * 1024, 1024, 384, 1024, 0, W + WL_BR + 640, 1024, 0, 1.0f, 0, gw, NGW, scr, lane);
            xpose_job(IN_(27) + (size_t)l * 1024 * 1024, 1024, 1024, 1024, 0, W + WL_OUT, 1024, 0, 1.0f, 0, gw, NGW, scr, lane);
            xpose_job(IN_(28) + (size_t)l * 1024 * NFFI, NFFI, 1024, NFFI, 0, W + WL_FFI, 1024, 0, 1.0f, 1, gw, NGW, scr, lane);
            xpose_job(IN_(29) + (size_t)l * FFH * 1024, 1024, FFH, 1024, 0, W + WL_FFO, FFH, 0, 1.0f, 0, gw, NGW, scr, lane);
            xpose_job(IN_(17) + (size_t)l * 256 * 256, 256, 256, 256, 0, W + WL_GLU, 256, 0, 1.0f, 0, gw, NGW, scr, lane);
            for (size_t i = (size_t)blk * 512 + tid; i < (size_t)224 * 1024 / 8; i += (size_t)G * 512) *(u32x4*)(W + WL_MIX + (size_t)2592 * 1024 + i * 8) = (u32x4){0u, 0u, 0u, 0u};
        }
    }
    for (int idx = blk * 512 + fresh_tid(); idx < 2 * 16 * 2 * 32 * 16 * 4; idx += G * 512) {
        const int cq = idx & 3, c = (idx >> 2) & 15, tau = (idx >> 6) & 31, d = (idx >> 11) & 1, g = (idx >> 12) & 15, l = idx >> 16;
        const float* Tq = Tb + (size_t)l * TL_END;
        const float* cr = IN_(14) + (((size_t)l * 16 + g) * 16 + c) * 64; const float* ci = IN_(15) + (((size_t)l * 16 + g) * 16 + c) * 64;
        const float* apb = Tq + TL_AP + ((size_t)g * 2 + d) * 64 * 33 * 2 + tau * 2; const float* bpb = Tq + TL_BB + ((size_t)g * 2 + d) * 64 * 16 * 2 + cq * 8;
        f32x4 s4 = {0.f, 0.f, 0.f, 0.f};
#pragma unroll 4
        for (int p = 0; p < 64; ++p) { const f32v2_t a2 = *(const f32v2_t*)(apb + p * 66); const f32x4 b0 = *(const f32x4*)(bpb + p * 32), b1 = *(const f32x4*)(bpb + p * 32 + 4);
            const float wr_ = cr[p] * a2[0] - ci[p] * a2[1], wi_ = cr[p] * a2[1] + ci[p] * a2[0];
            s4[0] += wr_ * b0[0] - wi_ * b0[1]; s4[1] += wr_ * b0[2] - wi_ * b0[3]; s4[2] += wr_ * b1[0] - wi_ * b1[1]; s4[3] += wr_ * b1[2] - wi_ * b1[3]; }
        *(f32x4*)((float*)Tq + TL_KT + ((((size_t)g * 2 + d) * 32 + tau) * 16 + c) * 16 + cq * 4) = s4;
    }
    norm_mod_phase(IN_(0), IN_(2), IN_(6), MOD, 0, XN, blk, NGW, 0);
    XBAR();

    for (int l = 0; l < 2; ++l) {
        const int skip = (l == 1) ? 1 : 0, nMe = skip ? 256 : NRT;
#define W (Wb + (size_t)l * WL_END)
#define T (Tb + (size_t)l * TL_END)
#define MODl (MOD + (size_t)l * 33 * 6144)
#define slat (l == 0 ? IN_(0) : (const float*)OUT)
#define sctx (l == 0 ? IN_(2) : (const float*)CTXR)
        const MixP MP{PM, (l == 0) ? (bf16_t*)OUT : ST, DEC, Y, ROPE, IN_(19) + l * 8, IN_(20) + l * 384, IN_(21) + (size_t)l * 2 * 16 * 192, IN_(22) + l * 2 * 192, IN_(23) + l * 384};
        if (l != 0) { norm_mod_mid_phase((const bf16_t*)OUT, IN_(6) + l * 1024, MODl, 0, XN, blk, NGW, 0);
            XBAR(); }
        if (l == 0) {
        for (size_t idx = (size_t)blk * 512 + fresh_tid(); idx < (size_t)2 * 16 * 512 * 96; idx += (size_t)G * 512) {
            const int k8 = (int)(idx % 96), n = (int)((idx / 96) & 511), g = (int)((idx / (96 * 512)) & 15), l = (int)(idx / (96 * 512 * 16));
            const float* Tq = Tb + (size_t)l * TL_END; const int t = n >> 4, c = n & 15, k0 = k8 * 8; float v[8];
            if (k0 < 512) { const int s = k0 >> 4, cp0 = k0 & 15;
#pragma unroll
                for (int e = 0; e < 8; ++e) { float x = 0.f;
                    if (s <= t) x += Tq[TL_KT + ((((size_t)g * 2 + 0) * 32 + (t - s)) * 16 + c) * 16 + cp0 + e];
                    if (s >= t) x += Tq[TL_KT + ((((size_t)g * 2 + 1) * 32 + (s - t)) * 16 + c) * 16 + cp0 + e];
                    if (s == t && c == cp0 + e) x += IN_(16)[l * 256 + g * 16 + c];
                    v[e] = x; }
            } else { const int kk = k0 - 512, d = kk >> 7, ri = (kk >> 6) & 1, p0 = kk & 63, tau = (d == 0 ? t : 31 - t) + 1;
#pragma unroll
                for (int e = 0; e < 8; ++e) { const int p = p0 + e; const float* ap = Tq + TL_AP + ((((size_t)g * 2 + d) * 64 + p) * 33 + tau) * 2;
                    const float cr = IN_(14)[(((size_t)l * 16 + g) * 16 + c) * 64 + p], ci = IN_(15)[(((size_t)l * 16 + g) * 16 + c) * 64 + p];
                    v[e] = ri == 0 ? (cr * ap[0] - ci * ap[1]) : -(cr * ap[1] + ci * ap[0]); } }
            u32x4 w; w.x = pk2(v[0], v[1]); w.y = pk2(v[2], v[3]); w.z = pk2(v[4], v[5]); w.w = pk2(v[6], v[7]);
            *(u32x4*)(Wb + (size_t)l * WL_END + WL_KCAT + (((size_t)g * 512 + n) * 768 + k0)) = w;
        }
        for (size_t idx = (size_t)blk * 512 + fresh_tid(); idx < (size_t)2 * 16 * 256 * 64; idx += (size_t)G * 512) {
            const int k8 = (int)(idx & 63), n = (int)((idx >> 6) & 255), g = (int)((idx >> 14) & 15), l = (int)(idx >> 18);
            const float* Tq = Tb + (size_t)l * TL_END; const int d = n >> 7, ri = (n >> 6) & 1, p = n & 63, k0 = k8 * 8, s = k0 >> 4, cp0 = k0 & 15, e_ = d == 0 ? 31 - s : s;
            const float* ap = Tq + TL_AP + ((((size_t)g * 2 + d) * 64 + p) * 33 + e_) * 2; float v[8];
#pragma unroll
            for (int e = 0; e < 8; ++e) { const float* bp = Tq + TL_BB + ((((size_t)g * 2 + d) * 64 + p) * 16 + cp0 + e) * 2;
                v[e] = ri == 0 ? (ap[0] * bp[0] - ap[1] * bp[1]) : (ap[0] * bp[1] + ap[1] * bp[0]); }
            u32x4 w; w.x = pk2(v[0], v[1]); w.y = pk2(v[2], v[3]); w.z = pk2(v[4], v[5]); w.w = pk2(v[6], v[7]);
            *(u32x4*)(Wb + (size_t)l * WL_END + WL_WST + (((size_t)g * 256 + n) * 512 + k0)) = w;
        }
        }
        if (l == 0) { SchedPlain S{(const char*)XN, (const char*)(W + WL_MIX), (size_t)256 * 1024 * 2, (size_t)256 * 1024 * 2, NRT, NMIX / 256, 16, G, blk, 0};
          EpiInProj E{PM, UH}; pg8::gemm_phase(lds, 1024, 1024, S, E); }
        else { SchedInProjLast S{(const char*)XN, (const char*)(W + WL_MIX), G, blk}; EpiInProj E{PM, UH}; pg8::gemm_phase(lds, 1024, 1024, S, E); }
        XBAR();
#if DBG_STOP == 2
        if (l == 0) { dbg_digest_bf16(OUT, PM, (size_t)MROWS * PMLD, PMLD, 0, 2336, blk, G, true); dbg_digest_bf16(OUT, UH, (size_t)16 * 2304 * 768, 768, 0, 512, blk, G, false); return; }
#endif
        { SchedS5 S{(const char*)UH, (const char*)(W + WL_WST), 1, 512, 8, G, blk}; EpiS5State E{SS}; pg8::gemm_phase(lds, 768, 512, S, E); }
        __syncthreads();
        mix_state_phase(MP, (bf16_t*)(ws + WS_EX), lds, blk, G);
        XBAR();
#if DBG_STOP == 3
        if (l == 0) { dbg_digest_f32(OUT, DEC, (size_t)2 * 32 * 36 * 4 * 2 * 48, blk, G, true); return; }
#endif
        s5_scan_phase(T + TL_AP, SS, UH, blk, G);
        mix_scan_phase(MP, blk, G);
        XBAR();
#if DBG_STOP == 4
        if (l == 0) { dbg_digest_bf16(OUT, ST, ST_ELEMS, 48, 0, 48, blk, G, true); dbg_digest_bf16(OUT, UH, (size_t)16 * 2304 * 768, 768, 0, 768, blk, G, false); return; }
#endif
        { SchedS5 S{(const char*)UH, (const char*)(W + WL_KCAT), 2, 768, 12, G, blk}; EpiS5Out E{Y5}; pg8::gemm_phase(lds, 768, 768, S, E); }
        __syncthreads();
        mix_out_phase(MP, (const bf16_t*)(ws + WS_EX), lds, blk, G, skip);
        XBAR();
#if DBG_STOP == 5
        if (l == 0) { dbg_digest_bf16(OUT, Y, (size_t)MROWS * 1024, 1024, 256, 1024, blk, G, true); dbg_digest_bf16(OUT, Y5, (size_t)MROWS * 256, 256, 0, 256, blk, G, false); return; }
#endif
        { SchedPlain S{(const char*)Y5, (const char*)(W + WL_GLU), (size_t)256 * 256 * 2, (size_t)0, nMe, 1, 4, G, blk, skip};
          EpiGlu E{Y5, Y, IN_(18) + l * 256}; pg8::gemm_phase(lds, 256, 256, S, E); }
        if (l != 0) norm_mod_mid_phase((const bf16_t*)OUT, IN_(6) + l * 1024, MODl, 0, XN, blk, NGW, skip);
        XBAR();
#if DBG_STOP == 6
        if (l == 0) { dbg_digest_bf16(OUT, Y, (size_t)MROWS * 1024, 1024, 0, 1024, blk, G, true); dbg_digest_bf16(OUT, XN, (size_t)MROWS * 1024, 1024, 0, 1024, blk, G, false); return; }
#endif
        { SchedMerge S{(const char*)Y, (const char*)(W + WL_BR), (const char*)XN, (const char*)(W + WL_G), G, blk, nMe, skip};
          EpiMerge E{YB + (size_t)blk * 2 * 65536, M1}; pg8::gemm_phase(lds, 1024, 1024, S, E); }
        XBAR();
        { SchedPlain S{(const char*)M1, (const char*)(W + WL_OUT), (size_t)256 * 1024 * 2, (size_t)256 * 1024 * 2, nMe, 4, 16, G, blk, skip};
          if (l == 0) { EpiResidMid<false> E{IN_(0), IN_(2), (const bf16_t*)OUT, (bf16_t*)(WS_() + WS_R2), MODl + 2 * 1024}; pg8::gemm_phase(lds, 1024, 1024, S, E); }
          else { EpiResidMid<true> E{IN_(0), IN_(2), (const bf16_t*)OUT, (bf16_t*)(WS_() + WS_R2), MODl + 2 * 1024}; pg8::gemm_phase(lds, 1024, 1024, S, E); } }
        XBAR();
        norm_mod_mid_phase((const bf16_t*)(WS_() + WS_R2), IN_(7) + l * 1024, MODl, 3, XN, blk, NGW, skip);
        XBAR();
        { SchedPlain S{(const char*)XN, (const char*)(W + WL_FFI), (size_t)256 * 1024 * 2, (size_t)256 * 1024 * 2, nMe, NFFI / 256, 16, G, blk, skip};
          EpiSwiglu E{Hb}; pg8::gemm_phase(lds, 1024, 1024, S, E); }
        XBAR();
        { SchedPlain S{(const char*)Hb, (const char*)(W + WL_FFO), (size_t)256 * FFH * 2, (size_t)256 * FFH * 2, nMe, 4, FFH / 64, G, blk, skip};
          if (l == 0) { EpiResidOut<true> E{(const bf16_t*)(WS_() + WS_R2), OUT, (bf16_t*)OUT, MODl + 5 * 1024}; pg8::gemm_phase(lds, FFH, FFH, S, E); }
          else { EpiResidOut<true> E{(const bf16_t*)(WS_() + WS_R2), OUT, XN, MODl + 5 * 1024}; pg8::gemm_phase(lds, FFH, FFH, S, E); } }
        XBAR();
    }
    final_norm_bf16_phase(XN, OUT, IN_(30), blk, NGW);
}

#undef ws
#undef Wb
#undef Tb
#undef MOD
#undef ROPE
#undef CTXR
#undef XN
#undef ST
#undef DEC
#undef PM
#undef UH
#undef YB
#undef Hb
#undef Y
#undef M1
#undef Y5
#undef SS
#undef OUT
#undef W
#undef T
#undef MODl
#undef slat
#undef sctx
extern "C" void kernel_launch(void* const* d_in, const int* in_sizes, int n_in, void* d_out, int out_size, void* d_ws, size_t ws_size, hipStream_t stream) {
    static int grid_blocks = 0;
    if (!grid_blocks) {
        if (n_in != 31 || ws_size < WS_END) { fprintf(stderr, "kernel_launch: unexpected n_in %d or ws_size %zu (< %zu)\n", n_in, ws_size, (size_t)WS_END); grid_blocks = -1; return; }
        int dev = 0, cus = 0, per_cu = 0;
        hipGetDevice(&dev);
        hipDeviceGetAttribute(&cus, hipDeviceAttributeMultiprocessorCount, dev);
        hipFuncSetAttribute((const void*)fwd_megakernel, hipFuncAttributeMaxDynamicSharedMemorySize, LDS_BYTES);
        hipOccupancyMaxActiveBlocksPerMultiprocessor(&per_cu, (const void*)fwd_megakernel, 512, LDS_BYTES);
        if (per_cu < 1) { fprintf(stderr, "kernel_launch: occupancy query says %d blocks/CU\n", per_cu); per_cu = 1; }
        (void)hipGetLastError();
        grid_blocks = cus;
    }
    if (grid_blocks < 0) return;
    (void)hipMemsetAsync((unsigned char*)d_ws + WS_BAR, 0, BAR_BYTES, stream);
    Params p{};
    for (int i = 0; i < 31; ++i) p.in[i] = (const float*)d_in[i];
    p.out = (float*)d_out; p.ws = (unsigned char*)d_ws;
    void* args[] = {&p};
    hipError_t e = hipLaunchCooperativeKernel((const void*)fwd_megakernel, dim3(grid_blocks), dim3(512), args, LDS_BYTES, stream);
    if (e != hipSuccess) fprintf(stderr, "cooperative launch failed: %s (grid %d)\n", hipGetErrorString(e), grid_blocks);
}
```
